# Optimizing an MI355X kernel written in HIP

```python
import math
import jax, jax.numpy as jnp
from jax import lax
import numpy as np

D_MODEL = 2048
BATCH = 1
SEQ = 16384
DEPTH = 4

HEAD_DIM = 64
N_MIXERS = 4
MIX_WIDTH = D_MODEL
GROUP_WIDTH = MIX_WIDTH // N_MIXERS
GROUP_HEADS = GROUP_WIDTH // HEAD_DIM

A_KV_HEADS = 2
A_RADIUS = 128
C_KV_HEADS = 2
C_BLOCK = 128
ROPE_THETA = 10000.0
NA_ROWS = 8
NA_COLS = 16
D_CONFIGS = ((128, 1), (512, 4), (2048, 16))
GRID_W = 64
T5_BUCKETS = 32
T5_MAX_DIST = 1024
T5_HEADS = 2 * GROUP_HEADS
EPS = 1e-6
NEG = -1e30

KV_A = A_KV_HEADS * HEAD_DIM
KV_C = C_KV_HEADS * HEAD_DIM
SPLITS = (GROUP_WIDTH, KV_A, KV_A, GROUP_WIDTH,
          GROUP_WIDTH, GROUP_WIDTH, GROUP_WIDTH, GROUP_WIDTH,
          GROUP_WIDTH, KV_C, KV_C, GROUP_WIDTH,
          GROUP_WIDTH, GROUP_WIDTH, GROUP_WIDTH, GROUP_WIDTH)
IN_WIDTH = sum(SPLITS)

kernel_name = "hybrid_parallel_heads_bidir_encoder"


def rms_norm(x, w):
    xf = x.astype(jnp.float32)
    y = xf * lax.rsqrt(jnp.mean(xf * xf, axis=-1, keepdims=True) + EPS)
    return (y * w.astype(jnp.float32)).astype(x.dtype)


def t5_bucket(rel):
    half = T5_BUCKETS // 2
    exact = half // 2
    n = jnp.abs(rel)
    big = exact + (jnp.log(jnp.maximum(n, exact).astype(jnp.float32) / exact)
                   / math.log(T5_MAX_DIST / exact) * (half - exact)).astype(jnp.int32)
    big = jnp.minimum(big, half - 1)
    return jnp.where(rel > 0, half, 0) + jnp.where(n < exact, n, big)


def t5_window_bias(table, head_lo, blk, step):
    i = jnp.arange(blk)[:, None]
    c = jnp.arange(3 * blk)[None, :]
    rel = (c - blk - i) * step
    b = table.astype(jnp.float32)[t5_bucket(rel)][..., head_lo:head_lo + GROUP_HEADS]
    return jnp.transpose(b, (2, 0, 1))


def neighbour_blocks(x, blk):
    pad = [(0, 0), (blk, blk)] + [(0, 0)] * (x.ndim - 2)
    xp = jnp.pad(x, pad)
    nb = x.shape[1] // blk
    xb = xp.reshape(x.shape[0], nb + 2, blk, *x.shape[2:])
    return jnp.concatenate([xb[:, :-2], xb[:, 1:-1], xb[:, 2:]], axis=2)


def window_attention_stats(q, k, v, radius, bias):
    B, L, Hkv, G, dh = q.shape
    blk = radius
    Lp = -(-L // blk) * blk
    nb = Lp // blk
    qb = jnp.pad(q, [(0, 0), (0, Lp - L)] + [(0, 0)] * 3).reshape(B, nb, blk, Hkv, G, dh)
    padk = [(0, 0), (0, Lp - L)] + [(0, 0)] * 2
    kb = neighbour_blocks(jnp.pad(k, padk), blk)
    vb = neighbour_blocks(jnp.pad(v, padk), blk)
    s = jnp.einsum('bnqhgd,bnchd->bnhgqc', qb, kb).astype(jnp.float32) * dh ** -0.5 + bias
    qpos = jnp.arange(nb)[:, None, None] * blk + jnp.arange(blk)[None, :, None]
    kpos = jnp.arange(nb)[:, None, None] * blk + jnp.arange(3 * blk)[None, None, :] - blk
    valid = (jnp.abs(kpos - qpos) <= radius) & (kpos >= 0) & (kpos < L)
    s = jnp.where(valid[None, :, None, None], s, NEG)
    m = jnp.max(s, axis=-1)
    p = jnp.exp(s - m[..., None])
    l = jnp.sum(p, axis=-1)
    o = jnp.einsum('bnhgqc,bnchd->bnqhgd', p.astype(v.dtype), vb).astype(jnp.float32)
    o = o.reshape(B, Lp, Hkv, G, dh)[:, :L]
    m = jnp.transpose(m, (0, 1, 4, 2, 3)).reshape(B, Lp, Hkv, G)[:, :L]
    l = jnp.transpose(l, (0, 1, 4, 2, 3)).reshape(B, Lp, Hkv, G)[:, :L]
    return m, l, o


def mixer_window_sink(q, k, v, sink, bias):
    B, L = q.shape[:2]
    G = GROUP_HEADS // A_KV_HEADS
    qh = q.reshape(B, L, A_KV_HEADS, G, HEAD_DIM)
    kh = k.reshape(B, L, A_KV_HEADS, HEAD_DIM)
    vh = v.reshape(B, L, A_KV_HEADS, HEAD_DIM)
    m, l, o = window_attention_stats(qh, kh, vh, A_RADIUS, bias)
    sk = sink.astype(jnp.float32).reshape(A_KV_HEADS, G)
    m2 = jnp.maximum(m, sk)
    a = jnp.exp(m - m2)
    den = l * a + jnp.exp(sk - m2)
    out = o * (a / den)[..., None]
    return out.reshape(B, L, GROUP_WIDTH).astype(q.dtype)


def mixer_neighbourhood(q, k, v, rpb):
    B, L = q.shape[:2]
    H = GROUP_HEADS
    rows = L // GRID_W
    kr = min(NA_ROWS, rows)
    qg = q.reshape(B, rows, GRID_W, H, HEAD_DIM)
    kg = k.reshape(B, rows, GRID_W, H, HEAD_DIM)
    vg = v.reshape(B, rows, GRID_W, H, HEAD_DIM)
    cols = jnp.arange(GRID_W)
    col_start = jnp.clip(cols - NA_COLS // 2, 0, GRID_W - NA_COLS)
    col_idx = col_start[:, None] + jnp.arange(NA_COLS)[None, :]
    dc = col_idx - cols[:, None] + (NA_COLS - 1)
    rpb = rpb.astype(jnp.float32)

    def one_row(args):
        q_row, r = args
        start = jnp.clip(r - kr // 2, 0, rows - kr)
        kband = lax.dynamic_slice_in_dim(kg, start, kr, axis=1)[:, :, col_idx]
        vband = lax.dynamic_slice_in_dim(vg, start, kr, axis=1)[:, :, col_idx]
        dr = start + jnp.arange(kr) - r + (NA_ROWS - 1)
        bias = rpb[:, dr[None, :, None], dc[:, None, :]]
        s = jnp.einsum('bwhd,brwjhd->bhwrj', q_row, kband).astype(jnp.float32) * HEAD_DIM ** -0.5
        p = jax.nn.softmax(s + bias[None], axis=(-2, -1))
        return jnp.einsum('bhwrj,brwjhd->bwhd', p.astype(v.dtype), vband)

    out = lax.map(one_row, (jnp.moveaxis(qg, 1, 0), jnp.arange(rows)))
    return jnp.moveaxis(out, 0, 1).reshape(B, L, GROUP_WIDTH)


def axial_rope_tables(L):
    t = jnp.arange(L)
    row = (t // GRID_W).astype(jnp.float32)
    col = (t % GRID_W).astype(jnp.float32)
    axis_dim = HEAD_DIM // 2
    inv = ROPE_THETA ** (-jnp.arange(0, axis_dim, 2, dtype=jnp.float32) / axis_dim)
    ang = jnp.concatenate([row[:, None] * inv[None], col[:, None] * inv[None]], axis=-1)
    return jnp.cos(ang), jnp.sin(ang)


def apply_rope(x, cos, sin):
    xf = x.astype(jnp.float32).reshape(*x.shape[:-1], HEAD_DIM // 2, 2)
    x0, x1 = xf[..., 0], xf[..., 1]
    c = cos[None, :, None]
    s = sin[None, :, None]
    out = jnp.stack([x0 * c - x1 * s, x0 * s + x1 * c], axis=-1)
    return out.reshape(x.shape).astype(x.dtype)


def mixer_axial_dense(q, k, v, q_scale, k_scale, cos, sin):
    B, L = q.shape[:2]
    G = GROUP_HEADS // C_KV_HEADS
    qh = rms_norm(q.reshape(B, L, GROUP_HEADS, HEAD_DIM), q_scale)
    kh = rms_norm(k.reshape(B, L, C_KV_HEADS, HEAD_DIM), k_scale)
    qh = apply_rope(qh, cos, sin).reshape(B, L, C_KV_HEADS, G, HEAD_DIM)
    kh = apply_rope(kh, cos, sin)
    vh = v.reshape(B, L, C_KV_HEADS, HEAD_DIM)
    nb = L // C_BLOCK
    qb = jnp.moveaxis(qh.reshape(B, nb, C_BLOCK, C_KV_HEADS, G, HEAD_DIM), 1, 0)

    def one_block(qblk):
        s = jnp.einsum('bqhgd,bkhd->bhgqk', qblk, kh).astype(jnp.float32) * HEAD_DIM ** -0.5
        p = jax.nn.softmax(s, axis=-1)
        return jnp.einsum('bhgqk,bkhd->bqhgd', p.astype(vh.dtype), vh)

    out = lax.map(one_block, qb)
    return jnp.moveaxis(out, 0, 1).reshape(B, L, GROUP_WIDTH)


def mixer_dilated(q, k, v, biases):
    B, L = q.shape[:2]
    H = GROUP_HEADS
    ms, ls, os_ = [], [], []
    for (window, dil), bias in zip(D_CONFIGS, biases):
        radius = window // 2 // dil

        def to_sub(t):
            return (t.reshape(B, L // dil, dil, H, HEAD_DIM).transpose(0, 2, 1, 3, 4)
                    .reshape(B * dil, L // dil, H, HEAD_DIM))

        def from_sub(t):
            return t.reshape(B, dil, L // dil, *t.shape[2:]).swapaxes(1, 2).reshape(B, L, *t.shape[2:])

        m, l, o = window_attention_stats(to_sub(q)[:, :, :, None], to_sub(k), to_sub(v), radius, bias)
        ms.append(from_sub(m))
        ls.append(from_sub(l))
        os_.append(from_sub(o))
    mmax = jnp.maximum(jnp.maximum(ms[0], ms[1]), ms[2])
    scales = [jnp.exp(m - mmax) for m in ms]
    num = os_[0] * scales[0][..., None] + os_[1] * scales[1][..., None] + os_[2] * scales[2][..., None]
    den = ls[0] * scales[0] + ls[1] * scales[1] + ls[2] * scales[2]
    return (num / den[..., None]).reshape(B, L, GROUP_WIDTH).astype(q.dtype)


def setup_inputs(seed: int = 0) -> dict:
    key = jax.random.key(seed)
    ks = jax.random.split(key, 13)
    D = D_MODEL
    nrm = jax.random.normal
    f32 = jnp.float32
    return {
        "x": nrm(ks[0], (BATCH, SEQ, D), f32),
        "c": nrm(ks[1], (BATCH, D), f32),
        "w_ada": nrm(ks[2], (DEPTH, D, 3 * D), f32) * (0.5 * D ** -0.5),
        "b_ada": 0.02 * nrm(ks[3], (DEPTH, 3 * D), f32),
        "norm_w": 1.0 + 0.02 * nrm(ks[4], (DEPTH, D), f32),
        "w_in": nrm(ks[5], (DEPTH, D, IN_WIDTH), f32) * D ** -0.5,
        "w_out": nrm(ks[6], (DEPTH, MIX_WIDTH, D), f32) * MIX_WIDTH ** -0.5,
        "attn_sink": nrm(ks[7], (DEPTH, GROUP_HEADS), f32),
        "na_rpb": 0.1 * nrm(ks[8], (DEPTH, GROUP_HEADS, 2 * NA_ROWS - 1, 2 * NA_COLS - 1), f32),
        "q_norm_w": 1.0 + 0.02 * nrm(ks[9], (DEPTH, HEAD_DIM), f32),
        "k_norm_w": 1.0 + 0.02 * nrm(ks[10], (DEPTH, HEAD_DIM), f32),
        "t5_table": 0.1 * nrm(ks[11], (T5_BUCKETS, T5_HEADS), f32),
        "final_norm_w": 1.0 + 0.02 * nrm(ks[12], (D,), f32),
    }


def reference(x, c, w_ada, b_ada, norm_w, w_in, w_out, attn_sink, na_rpb, q_norm_w, k_norm_w,
              t5_table, final_norm_w):
    B, L, _ = x.shape
    g_a = GROUP_HEADS // A_KV_HEADS
    bias_a = t5_window_bias(t5_table, 0, A_RADIUS, 1).reshape(A_KV_HEADS, g_a, A_RADIUS, 3 * A_RADIUS)
    bias_d = tuple(t5_window_bias(t5_table, GROUP_HEADS, w // 2 // d, d)[:, None] for (w, d) in D_CONFIGS)
    cos, sin = axial_rope_tables(L)
    offsets = [sum(SPLITS[:j + 1]) for j in range(len(SPLITS) - 1)]
    cond = jax.nn.silu(c)
    for i in range(DEPTH):
        mod = cond @ w_ada[i] + b_ada[i]
        shift, scale, gate = jnp.split(mod, 3, axis=-1)
        h = rms_norm(x, norm_w[i]) * (1 + scale[:, None]) + shift[:, None]
        proj = h @ w_in[i]
        (q_a, k_a, v_a, z_a, q_b, k_b, v_b, z_b,
         q_c, k_c, v_c, z_c, q_d, k_d, v_d, z_d) = jnp.split(proj, offsets, axis=-1)
        y_a = mixer_window_sink(q_a, k_a, v_a, attn_sink[i], bias_a)
        y_b = mixer_neighbourhood(q_b, k_b, v_b, na_rpb[i])
        y_c = mixer_axial_dense(q_c, k_c, v_c, q_norm_w[i], k_norm_w[i], cos, sin)
        y_d = mixer_dilated(q_d, k_d, v_d, bias_d)
        y = jnp.concatenate([y_a * jax.nn.silu(z_a), y_b * jax.nn.silu(z_b),
                             y_c * jax.nn.silu(z_c), y_d * jax.nn.silu(z_d)], axis=-1)
        x = x + gate[:, None] * (y @ w_out[i])
    return rms_norm(x, final_norm_w)
```

```cpp
#include <hip/hip_runtime.h>
#include <hip/hip_cooperative_groups.h>
#include <hip/hip_bf16.h>
#include <cstdio>
#include <cstdint>
#include <cmath>
namespace cg = cooperative_groups;

#ifndef MK_ONE_LAUNCH
#define MK_ONE_LAUNCH 1
#endif

#define LAS __attribute__((address_space(3)))
#define GAS __attribute__((address_space(1)))
typedef unsigned short bf16_t;
typedef short bf16x8 __attribute__((ext_vector_type(8)));
typedef float f32x4 __attribute__((ext_vector_type(4)));
typedef float f32x2 __attribute__((ext_vector_type(2)));
typedef float f32x16 __attribute__((ext_vector_type(16)));
typedef unsigned u32x4 __attribute__((ext_vector_type(4)));
typedef unsigned u32x2 __attribute__((ext_vector_type(2)));

constexpr int SEQ = 16384, DMODEL = 2048, NIN = 6656, DEPTH = 4;
constexpr int PP = NIN + 64;
constexpr int VTPP = 2 * SEQ + 64;
__host__ __device__ __forceinline__ int vt_off(int d, int p) { return (d >> 1) * VTPP + (p >> 5) * 64 + (d & 1) * 32 + (p & 31); }
constexpr int C_QA = 0, C_KA = 512, C_VA = 640, C_ZA = 768, C_QB = 1280, C_KB = 1792, C_VB = 2304, C_ZB = 2816;
constexpr int C_QC = 3328, C_KC = 3840, C_VC = 3968, C_ZC = 4096, C_QD = 4608, C_KD = 5120, C_VD = 5632, C_ZD = 6144;
constexpr float LOG2E = 1.4426950408889634f;
constexpr float C2 = 0.125f * LOG2E;
constexpr float EPS = 1e-6f;
constexpr float NEGBIG = -1e30f;

constexpr size_t MiB = 1u << 20;
constexpr size_t WS_MODV = 1 * MiB;
constexpr size_t WS_TABA = 1 * MiB + 128 * 1024;
constexpr size_t WS_TABD = 1 * MiB + 192 * 1024;
constexpr size_t WS_CS = 2 * MiB;
constexpr size_t WS_WINT = 8 * MiB;
constexpr size_t WS_WOUTT = 112 * MiB;
constexpr size_t WS_H = 144 * MiB;
constexpr size_t WS_PROJ = 208 * MiB;
constexpr size_t WS_VTA = 420 * MiB;
constexpr size_t WS_VTB = 426 * MiB;
constexpr size_t WS_VTD = 444 * MiB;
constexpr size_t WS_Y = 462 * MiB;
constexpr size_t WS_XR = 526 * MiB;
constexpr size_t WS_HO = 654 * MiB;
constexpr size_t WS_HL = 672 * MiB;
constexpr size_t WS_END = 674 * MiB;
static_assert(WS_PROJ + (size_t)SEQ * PP * 2 <= WS_VTA && WS_VTA + (size_t)64 * VTPP * 2 <= WS_VTB && WS_VTB + (size_t)256 * VTPP * 2 <= WS_VTD && WS_VTD + (size_t)256 * VTPP * 2 <= WS_Y, "d_ws map");
constexpr int TABA_N = 320, TABA_C = 160, TABD_N = 3073, TABD_C = 1536;

constexpr int NWAVES = 8;
constexpr int LDS_BYTES = 147456;

typedef float f32x2_c __attribute__((ext_vector_type(2))); typedef __bf16 bf16x2_c __attribute__((ext_vector_type(2)));
__device__ __forceinline__ unsigned cvt_pk_bf16(float lo, float hi) { f32x2_c v = {lo, hi}; bf16x2_c b = __builtin_convertvector(v, bf16x2_c); return __builtin_bit_cast(unsigned, b); }
__device__ __forceinline__ float bf_lo(unsigned u) { return __builtin_bit_cast(float, u << 16); }
__device__ __forceinline__ float bf_hi(unsigned u) { return __builtin_bit_cast(float, u & 0xffff0000u); }
__device__ __forceinline__ float silu_f(float z) { return z / (1.f + __expf(-z)); }
__device__ __forceinline__ float wave_sum(float v) {
#pragma unroll
    for (int o = 1; o < 64; o <<= 1) v += __shfl_xor(v, o);
    return v;
}

namespace pg8 {
constexpr int BM = 256, BK = 64, HALF = 128, HTB = HALF * BK * 2, STAGE_BYTES = 8 * HTB, NXCD = 8, WGM = 8;
__host__ __device__ __forceinline__ int lds_byte(int r, int c) { const int st = (r >> 4) * 2 + (c >> 5), rr = r & 15, cc = c & 31, ob = rr * 64 + cc * 2; return st * 1024 + (ob ^ (((ob >> 9) & 1) << 5)); }
__host__ __device__ __forceinline__ void stage_rc(int b, int& R, int& C) { const int st = b / 1024, sb = b % 1024, swz = sb ^ (((sb >> 9) & 1) << 5); R = (st >> 1) * 16 + swz / 64; C = (st & 1) * 32 + (swz % 64) / 2; }
__host__ __device__ __forceinline__ int perm32(int rho) { const int n = rho >> 4, i = rho & 15; return 8 * (i >> 2) + 4 * n + (i & 3); }

struct Unit { const char* a; const char* b; unsigned ldb2; int kind, pm, pn; };

template <class Epi, class Sched>
__device__ __forceinline__ void gemm_phase(const int tid, LAS unsigned char* lds, const int K, const Sched& S, const Epi& E) {
    const int wid = __builtin_amdgcn_readfirstlane(tid >> 6), lane = tid & 63, wr = wid >> 2, wc = wid & 3, fr = lane & 15, fq = lane >> 4;
    const int nt = K / BK;
    unsigned voffA[2], rB[2], cB2[2];
#pragma unroll
    for (int i = 0; i < 2; ++i) { int R, C; stage_rc(tid * 16 + i * 8192, R, C); const int Rb = (R & ~31) + perm32(R & 31);
        voffA[i] = (unsigned)(R * K + C) * 2u; rB[i] = (unsigned)Rb; cB2[i] = (unsigned)C * 2u; }
    const size_t kstep = (size_t)(BK * 2);
    const size_t hstepA = (size_t)HALF * K * 2;
    const unsigned ldsw = (unsigned)wid * 1024u;
    const int aoff = lds_byte(wr * 64 + fr, fq * 8), boff = lds_byte(wc * 32 + fr, fq * 8);
#define PG8_SA(b, h) (((b) * 2 + (h)) * HTB)
#define PG8_SB(b, h) ((4 + (b) * 2 + (h)) * HTB)
#define PG8_STAGE(bufoff, gbase, v0, v1) do { \
        __builtin_amdgcn_global_load_lds((const unsigned*)((const char*)(gbase) + (v0)), (LAS unsigned*)(lds + (bufoff) + ldsw), 16, 0, 0); \
        __builtin_amdgcn_global_load_lds((const unsigned*)((const char*)(gbase) + (v1)), (LAS unsigned*)(lds + (bufoff) + ldsw + 8192), 16, 0, 0); } while (0)
#define PG8_LDA(dst, b, h) do { _Pragma("unroll") for (int m = 0; m < 4; ++m) _Pragma("unroll") for (int k = 0; k < 2; ++k) dst[m][k] = *(const LAS bf16x8*)(lds + PG8_SA(b, h) + aoff + m * 2048 + k * 1024); } while (0)
#define PG8_LDB(dst, b, h) do { _Pragma("unroll") for (int n = 0; n < 2; ++n) _Pragma("unroll") for (int k = 0; k < 2; ++k) dst[n][k] = *(const LAS bf16x8*)(lds + PG8_SB(b, h) + boff + n * 2048 + k * 1024); } while (0)
#define PG8_MMA(ai, bj, At, Bt) do { __builtin_amdgcn_s_setprio(1); _Pragma("unroll") for (int m = 0; m < 4; ++m) _Pragma("unroll") for (int n = 0; n < 2; ++n) _Pragma("unroll") for (int k = 0; k < 2; ++k) \
        acc[ai][bj][m][n] = __builtin_amdgcn_mfma_f32_16x16x32_bf16(Bt[n][k], At[m][k], acc[ai][bj][m][n], 0, 0, 0); __builtin_amdgcn_s_setprio(0); } while (0)
#define PG8_WAIT_V(n) asm volatile("s_waitcnt vmcnt(" #n ")" ::: "memory")
#define PG8_WAIT_L(n) asm volatile("s_waitcnt lgkmcnt(" #n ")" ::: "memory")
#define PG8_BAR __builtin_amdgcn_s_barrier()
#define PG8_SCHED __builtin_amdgcn_sched_barrier(0)
    Unit cur, nxt; int ui = 0;
    if (!S.next(0, cur)) return;
    f32x4 acc[2][2][4][2];
#pragma unroll
    for (int a = 0; a < 2; ++a)
#pragma unroll
        for (int b = 0; b < 2; ++b)
#pragma unroll
            for (int m = 0; m < 4; ++m)
#pragma unroll
                for (int n = 0; n < 2; ++n) acc[a][b][m][n] = (f32x4){0.f, 0.f, 0.f, 0.f};
    bf16x8 At[4][2], B0[2][2], B1[2][2];
    const char* cA = cur.a; const char* cB = cur.b;
    unsigned vc0 = rB[0] * cur.ldb2 + cB2[0], vc1 = rB[1] * cur.ldb2 + cB2[1]; size_t hBc = (size_t)HALF * cur.ldb2;
    {
        PG8_STAGE(PG8_SB(0, 0), cB, vc0, vc1); PG8_STAGE(PG8_SB(0, 1), cB + hBc, vc0, vc1); PG8_STAGE(PG8_SA(0, 0), cA, voffA[0], voffA[1]); PG8_STAGE(PG8_SA(0, 1), cA + hstepA, voffA[0], voffA[1]);
        if (wr == 1) PG8_BAR;
        PG8_WAIT_V(2); PG8_BAR;
        PG8_STAGE(PG8_SB(1, 0), cB + kstep, vc0, vc1); PG8_STAGE(PG8_SA(1, 0), cA + kstep, voffA[0], voffA[1]); PG8_STAGE(PG8_SB(1, 1), cB + hBc + kstep, vc0, vc1);
        PG8_WAIT_V(6); PG8_BAR;
    }
    for (;;) {
        const bool has_next = S.next(ui + 1, nxt);
        const char* nA = has_next ? nxt.a : cA; const char* nB = has_next ? nxt.b : cB;
        const unsigned nldb = has_next ? nxt.ldb2 : cur.ldb2;
        const unsigned vn0 = rB[0] * nldb + cB2[0], vn1 = rB[1] * nldb + cB2[1]; const size_t hBn = (size_t)HALF * nldb;
        for (int t = 0; t < nt; t += 2) {
            const bool last = (t == nt - 2);
            const char* a1 = cA + (size_t)(t + 1) * kstep;
            const char* a2 = last ? nA : cA + (size_t)(t + 2) * kstep; const char* b2 = last ? nB : cB + (size_t)(t + 2) * kstep;
            const char* a3 = a2 + kstep; const char* b3 = b2 + kstep;
            const unsigned v20 = last ? vn0 : vc0, v21 = last ? vn1 : vc1; const size_t hB2 = last ? hBn : hBc;
            PG8_LDB(B0, 0, 0); PG8_LDB(B1, 0, 1); PG8_SCHED; PG8_LDA(At, 0, 0); PG8_STAGE(PG8_SA(1, 1), a1 + hstepA, voffA[0], voffA[1]);
            PG8_WAIT_V(8); PG8_WAIT_L(0); PG8_BAR; PG8_MMA(0, 0, At, B0); PG8_MMA(0, 1, At, B1); PG8_BAR; PG8_SCHED;
            PG8_LDA(At, 0, 1); PG8_STAGE(PG8_SB(0, 0), b2, v20, v21); PG8_STAGE(PG8_SB(0, 1), b2 + hB2, v20, v21); PG8_STAGE(PG8_SA(0, 0), a2, voffA[0], voffA[1]);
            PG8_WAIT_V(8); PG8_WAIT_L(0); PG8_BAR; PG8_MMA(1, 0, At, B0); PG8_MMA(1, 1, At, B1); PG8_BAR; PG8_SCHED;
            PG8_LDB(B0, 1, 0); PG8_LDB(B1, 1, 1); PG8_SCHED; PG8_LDA(At, 1, 0); PG8_STAGE(PG8_SA(0, 1), a2 + hstepA, voffA[0], voffA[1]);
            PG8_WAIT_V(8); PG8_WAIT_L(0); PG8_BAR; PG8_MMA(0, 0, At, B0); PG8_MMA(0, 1, At, B1); PG8_BAR; PG8_SCHED;
            PG8_LDA(At, 1, 1); PG8_STAGE(PG8_SB(1, 0), b3, v20, v21); PG8_STAGE(PG8_SB(1, 1), b3 + hB2, v20, v21); PG8_STAGE(PG8_SA(1, 0), a3, voffA[0], voffA[1]);
            PG8_WAIT_V(8); PG8_WAIT_L(0); PG8_BAR; PG8_MMA(1, 0, At, B0); PG8_MMA(1, 1, At, B1); PG8_BAR; PG8_SCHED;
        }
        if (wr == 0) PG8_BAR;
        E(acc, cur, wr, wc, fr, fq);
        if (!has_next) break;
#pragma unroll
        for (int a = 0; a < 2; ++a)
#pragma unroll
            for (int b = 0; b < 2; ++b)
#pragma unroll
                for (int m = 0; m < 4; ++m)
#pragma unroll
                    for (int n = 0; n < 2; ++n) acc[a][b][m][n] = (f32x4){0.f, 0.f, 0.f, 0.f};
        cur = nxt; cA = nA; cB = nB; vc0 = vn0; vc1 = vn1; hBc = hBn; ++ui;
        if (wr == 1) PG8_BAR;
    }
    PG8_WAIT_V(0);
    PG8_BAR;
#undef PG8_SA
#undef PG8_SB
#undef PG8_STAGE
#undef PG8_LDA
#undef PG8_LDB
#undef PG8_MMA
#undef PG8_WAIT_V
#undef PG8_WAIT_L
#undef PG8_BAR
#undef PG8_SCHED
}

__device__ __forceinline__ void grouped(int wgid, int nM, int nN, int& pm, int& pn) {
    const int nwg = nM * nN; { const int q = nwg / NXCD, r = nwg % NXCD, xcd = wgid % NXCD, off = wgid / NXCD; wgid = (xcd < r ? xcd * (q + 1) : r * (q + 1) + (xcd - r) * q) + off; }
    const int nig = WGM * nN, gid = wgid / nig, fm = gid * WGM, gsz = (nM - fm) < WGM ? (nM - fm) : WGM;
    pm = fm + ((wgid % nig) % gsz); pn = (wgid % nig) / gsz;
}

struct SchedIn {
    const char* H; const char* W; int G, c;
    __device__ __forceinline__ bool next(int i, Unit& u) const {
        const int Lx = i * G + c; if (Lx >= 1728) return false;
        if (Lx < 1408) { int pm, pi; grouped(Lx, 64, 22, pm, pi); const int pn = pi + (pi >= 9 ? 2 : 0) + (pi >= 20 ? 2 : 0);
            u.a = H + (size_t)pm * 256 * DMODEL * 2; u.b = W + (size_t)pn * 256 * DMODEL * 2; u.ldb2 = DMODEL * 2; u.kind = 0; u.pm = pm; u.pn = pn; }
        else { const int l2 = Lx - 1408, ft = l2 >> 6, tt = l2 & 63; const int pmf = ft == 0 ? 2 : (ft == 1 ? 9 : (ft == 2 ? 10 : (ft == 3 ? 22 : 23)));
            u.a = W + (size_t)pmf * 256 * DMODEL * 2;
            if (ft < 3) { u.b = H + (size_t)tt * 256 * DMODEL * 2; u.ldb2 = DMODEL * 2; }
            else { u.b = H + (size_t)(16 * 256 * (tt & 3) + (tt >> 2)) * DMODEL * 2; u.ldb2 = 16 * DMODEL * 2; }
            u.kind = 1; u.pm = ft; u.pn = tt; }
        return true;
    }
};
struct SchedOut {
    const char* Y; const char* W; int G, c;
    __device__ __forceinline__ bool next(int i, Unit& u) const {
        const int Lx = i * G + c; if (Lx >= 512) return false;
        int pm, pn; grouped(Lx, 64, 8, pm, pn);
        u.a = Y + (size_t)pm * 256 * DMODEL * 2; u.b = W + (size_t)pn * 256 * DMODEL * 2; u.ldb2 = DMODEL * 2; u.kind = 0; u.pm = pm; u.pn = pn; return true;
    }
};

struct EpiIn {
    bf16_t* PROJ; bf16_t* VTA; bf16_t* VTB; bf16_t* VTD; const float* CS; const float* qnw; const float* knw;
    __device__ __forceinline__ void operator()(const f32x4 (&acc)[2][2][4][2], const Unit& u, int wr, int wc, int fr, int fq) const {
        asm volatile("" : "+v"(fr), "+v"(fq));
        if (u.kind == 1) {
            const int ft = u.pm, tt = u.pn; bf16_t* base; int fbase, ai_lo = 0;
            if (ft == 0) { base = VTA; fbase = -128; ai_lo = 1; } else if (ft < 3) { base = VTB; fbase = (ft - 1) * 256; } else { base = VTD; fbase = (ft - 3) * 256; }
            for (int ai = ai_lo; ai < 2; ++ai)
#pragma unroll
                for (int m = 0; m < 4; ++m) { bf16_t* rowp = base + vt_off(fbase + 128 * ai + 64 * wr + 16 * m + fr, 256 * tt + 32 * wc + 8 * fq);
#pragma unroll
                    for (int bj = 0; bj < 2; ++bj) { const f32x4 v0 = ai ? acc[1][bj][m][0] : acc[0][bj][m][0], v1 = ai ? acc[1][bj][m][1] : acc[0][bj][m][1];
                        u32x4 w; w.x = cvt_pk_bf16(v0[0], v0[1]); w.y = cvt_pk_bf16(v0[2], v0[3]); w.z = cvt_pk_bf16(v1[0], v1[1]); w.w = cvt_pk_bf16(v1[2], v1[3]);
                        *(u32x4*)(rowp + bj * 256) = w; } }
            return;
        }
        const int pn = u.pn; const int row0 = u.pm * BM + wr * 64 + fr;
        if (pn >= 13 && pn <= 15) {
            const bool nrm = (pn < 15) || (wc < 2); const float* nw = (pn < 15) ? qnw : knw; const float sc = (pn < 15) ? C2 : 1.f;
            f32x4 wv[2][2];
#pragma unroll
            for (int bj = 0; bj < 2; ++bj)
#pragma unroll
                for (int n = 0; n < 2; ++n) wv[bj][n] = *(const f32x4*)(nw + 32 * bj + 8 * fq + 4 * n);
#pragma unroll
            for (int ai = 0; ai < 2; ++ai)
#pragma unroll
                for (int m = 0; m < 4; ++m) { const int row = row0 + ai * HALF + m * 16; bf16_t* rowp = PROJ + (size_t)row * PP + pn * 256 + 64 * wc + 8 * fq;
                    f32x4 v[2][2];
#pragma unroll
                    for (int bj = 0; bj < 2; ++bj)
#pragma unroll
                        for (int n = 0; n < 2; ++n) v[bj][n] = acc[ai][bj][m][n];
                    if (nrm) {
                        float ss = 0.f;
#pragma unroll
                        for (int bj = 0; bj < 2; ++bj)
#pragma unroll
                            for (int n = 0; n < 2; ++n) ss += v[bj][n][0] * v[bj][n][0] + v[bj][n][1] * v[bj][n][1] + v[bj][n][2] * v[bj][n][2] + v[bj][n][3] * v[bj][n][3];
                        ss += __shfl_xor(ss, 16); ss += __shfl_xor(ss, 32);
                        const float rinv = __builtin_amdgcn_rsqf(ss * (1.f / 64.f) + EPS);
#pragma unroll
                        for (int bj = 0; bj < 2; ++bj)
#pragma unroll
                            for (int n = 0; n < 2; ++n) { const f32x4 x = v[bj][n] * wv[bj][n] * rinv; const f32x4 cs = *(const f32x4*)(CS + ((size_t)row * 32 + 16 * bj + 4 * fq + 2 * n) * 2);
                                f32x4 o; o[0] = x[0] * cs[0] - x[1] * cs[1]; o[1] = x[0] * cs[1] + x[1] * cs[0]; o[2] = x[2] * cs[2] - x[3] * cs[3]; o[3] = x[2] * cs[3] + x[3] * cs[2]; v[bj][n] = o * sc; }
                    }
#pragma unroll
                    for (int bj = 0; bj < 2; ++bj) { u32x4 w; w.x = cvt_pk_bf16(v[bj][0][0], v[bj][0][1]); w.y = cvt_pk_bf16(v[bj][0][2], v[bj][0][3]); w.z = cvt_pk_bf16(v[bj][1][0], v[bj][1][1]); w.w = cvt_pk_bf16(v[bj][1][2], v[bj][1][3]);
                        *(u32x4*)(rowp + 32 * bj) = w; } }
            return;
        }
        const float sc = (pn == 0 || pn == 1 || pn == 5 || pn == 6 || pn == 18 || pn == 19) ? C2 : 1.f;
        const int col0 = pn * BM + wc * 32 + 8 * fq;
#pragma unroll
        for (int ai = 0; ai < 2; ++ai)
#pragma unroll
            for (int m = 0; m < 4; ++m) { bf16_t* rowp = PROJ + (size_t)(row0 + ai * HALF + m * 16) * PP + col0;
#pragma unroll
                for (int bj = 0; bj < 2; ++bj) { const f32x4 v0 = acc[ai][bj][m][0] * sc, v1 = acc[ai][bj][m][1] * sc;
                    u32x4 w; w.x = cvt_pk_bf16(v0[0], v0[1]); w.y = cvt_pk_bf16(v0[2], v0[3]); w.z = cvt_pk_bf16(v1[0], v1[1]); w.w = cvt_pk_bf16(v1[2], v1[3]);
                    *(u32x4*)(rowp + bj * HALF) = w; } }
    }
};

struct EpiOut {
    const float* xin; float* xout; const float* gate;
    __device__ __forceinline__ void operator()(const f32x4 (&acc)[2][2][4][2], const Unit& u, int wr, int wc, int fr, int fq) const {
        asm volatile("" : "+v"(fr), "+v"(fq));
        const int row0 = u.pm * BM + wr * 64 + fr, col0 = u.pn * BM + wc * 32 + 8 * fq;
        f32x4 g[2][2];
#pragma unroll
        for (int bj = 0; bj < 2; ++bj)
#pragma unroll
            for (int n = 0; n < 2; ++n) g[bj][n] = *(const f32x4*)(gate + col0 + bj * HALF + 4 * n);
#pragma unroll
        for (int ai = 0; ai < 2; ++ai)
#pragma unroll
            for (int m = 0; m < 4; ++m) { const size_t ro = (size_t)(row0 + ai * HALF + m * 16) * DMODEL + col0;
#pragma unroll
                for (int bj = 0; bj < 2; ++bj)
#pragma unroll
                    for (int n = 0; n < 2; ++n) { const f32x4 x = *(const f32x4*)(xin + ro + bj * HALF + 4 * n); *(f32x4*)(xout + ro + bj * HALF + 4 * n) = x + g[bj][n] * acc[ai][bj][m][n]; } }
    }
};
}

namespace attn_body {
using bf16 = __hip_bfloat16;
using s16x4 = __attribute__((ext_vector_type(4))) short;
constexpr int D = 64, NW = 8, QBLK = 32, QB = QBLK * NW, KVBLK = 64;
__device__ __forceinline__ int crow(int r, int hi) { return (r & 3) + 8 * (r >> 2) + 4 * hi; }
#define SBAR() __builtin_amdgcn_sched_barrier(0)
constexpr int NSLOT = 3, SLOTB = 8192;
constexpr int LDS_K = 0, LDS_V = NSLOT * SLOTB, LDS_WS = 2 * NSLOT * SLOTB, LDS_OST = LDS_WS + NW * 64 * 4, LDS_BYTES = LDS_OST + NW * 4096;
__device__ __forceinline__ void glds16(const void* gsrc, unsigned lds_dst) { unsigned keep;
  asm volatile("s_mov_b32 %0, m0\n\ts_mov_b32 m0, %2\n\ts_nop 0\n\tglobal_load_lds_dwordx4 %1, off\n\ts_mov_b32 m0, %0" : "=&s"(keep) : "v"(gsrc), "s"(lds_dst) : "memory"); }
__device__ __forceinline__ float max3f(float a, float b, float c) { float r; asm("v_max3_f32 %0, %1, %2, %3" : "=v"(r) : "v"(a), "v"(b), "v"(c)); return r; }
__device__ __forceinline__ float max2f(float a, float b) { float r; asm("v_max_f32_e32 %0, %1, %2" : "=v"(r) : "v"(a), "v"(b)); return r; }
__device__ __forceinline__ float fadd_s(float a, float b) { float r; asm("v_add_f32_e32 %0, %1, %2" : "=v"(r) : "v"(a), "v"(b)); return r; }
__device__ __forceinline__ float fsub_s(float a, float b) { float r; asm("v_sub_f32_e32 %0, %1, %2" : "=v"(r) : "v"(a), "v"(b)); return r; }
typedef float f32x2_t __attribute__((ext_vector_type(2))); typedef __bf16 bf16x2_t __attribute__((ext_vector_type(2)));
__device__ __forceinline__ unsigned cvtpk_s(float lo, float hi) { f32x2_t v = {lo, hi}; bf16x2_t b = __builtin_convertvector(v, bf16x2_t); return __builtin_bit_cast(unsigned, b); }
#define WAIT_BAR(N) asm volatile("s_waitcnt vmcnt(" #N ") lgkmcnt(0)\n\ts_barrier" ::: "memory")
__device__ __forceinline__ void qkt(f32x16& p0, f32x16& p1, const char* Kslot, const bf16x8* qr, const f32x16& negm, int r32, int hi) {
  const char* kb = Kslot + hi * 1024 + r32 * 16;
  #pragma unroll
  for (int d0 = 0; d0 < 4; ++d0) {
    const bf16x8 b0 = *reinterpret_cast<const bf16x8*>(kb + d0 * 2048);
    const bf16x8 b1 = *reinterpret_cast<const bf16x8*>(kb + d0 * 2048 + 512);
    if (d0 == 0) { p0 = __builtin_amdgcn_mfma_f32_32x32x16_bf16(b0, qr[0], negm, 0, 0, 0); p1 = __builtin_amdgcn_mfma_f32_32x32x16_bf16(b1, qr[0], negm, 0, 0, 0); }
    else { p0 = __builtin_amdgcn_mfma_f32_32x32x16_bf16(b0, qr[d0], p0, 0, 0, 0); p1 = __builtin_amdgcn_mfma_f32_32x32x16_bf16(b1, qr[d0], p1, 0, 0, 0); } }
}
typedef __attribute__((address_space(3))) const char* lds_cptr;
typedef short v4i16_t __attribute__((ext_vector_type(4)));
__device__ __forceinline__ void kload8(bf16x8* kf, lds_cptr kp) {
  kf[0] = *(const LAS bf16x8*)(kp);        kf[1] = *(const LAS bf16x8*)(kp + 512);
  kf[2] = *(const LAS bf16x8*)(kp + 2048); kf[3] = *(const LAS bf16x8*)(kp + 2560);
  kf[4] = *(const LAS bf16x8*)(kp + 4096); kf[5] = *(const LAS bf16x8*)(kp + 4608);
  kf[6] = *(const LAS bf16x8*)(kp + 6144); kf[7] = *(const LAS bf16x8*)(kp + 6656);
}
__device__ __forceinline__ void kload2(bf16x8* kf, lds_cptr kp, int j) { kf[2 * j] = *(const LAS bf16x8*)(kp + j * 2048); kf[2 * j + 1] = *(const LAS bf16x8*)(kp + j * 2048 + 512); }
__device__ __forceinline__ s16x4 vtr(lds_cptr p) { return __builtin_bit_cast(s16x4, __builtin_amdgcn_ds_read_tr16_b64_v4i16((LAS v4i16_t*)p)); }
__device__ __forceinline__ float rowmax(const f32x16& p0, const f32x16& p1) {
  float a = max3f(p0[0], p0[1], p1[0]), b = max3f(p0[2], p0[3], p1[1]); a = max3f(a, p1[2], p1[3]);
  #pragma unroll
  for (int r = 4; r < 16; r += 4) { a = max3f(a, p0[r], p0[r + 1]); b = max3f(b, p0[r + 2], p0[r + 3]); a = max3f(a, p1[r], p1[r + 1]); b = max3f(b, p1[r + 2], p1[r + 3]); }
  const float m = max2f(a, b);
  auto rr = __builtin_amdgcn_permlane32_swap(__float_as_uint(m), __float_as_uint(m), false, false);
  return max2f(__uint_as_float(rr[0]), __uint_as_float(rr[1]));
}
__device__ __forceinline__ void pv(f32x16* o, int vb, bf16x8 pa0, bf16x8 pa1, bf16x8 pa2, bf16x8 pa3) {
  #pragma unroll
  for (int d0 = 0; d0 < 2; ++d0) { s16x4 lo[4], hi[4];
    #pragma unroll
    for (int ks = 0; ks < 4; ++ks) {
      asm volatile("ds_read_b64_tr_b16 %0,%1 offset:%c2" : "=&v"(lo[ks]) : "v"(vb), "i"(d0 * 4096 + ks * 1024) : "memory");
      asm volatile("ds_read_b64_tr_b16 %0,%1 offset:%c2" : "=&v"(hi[ks]) : "v"(vb), "i"(d0 * 4096 + ks * 1024 + 512) : "memory"); }
    asm volatile("s_waitcnt lgkmcnt(0)" ::: "memory"); SBAR();
    #define PK(k) (bf16x8){lo[k][0], lo[k][1], lo[k][2], lo[k][3], hi[k][0], hi[k][1], hi[k][2], hi[k][3]}
    o[d0] = __builtin_amdgcn_mfma_f32_32x32x16_bf16(pa0, PK(0), o[d0], 0, 0, 0);
    o[d0] = __builtin_amdgcn_mfma_f32_32x32x16_bf16(pa1, PK(1), o[d0], 0, 0, 0);
    o[d0] = __builtin_amdgcn_mfma_f32_32x32x16_bf16(pa2, PK(2), o[d0], 0, 0, 0);
    o[d0] = __builtin_amdgcn_mfma_f32_32x32x16_bf16(pa3, PK(3), o[d0], 0, 0, 0);
    #undef PK
  }
}

template <int THRL> __device__ __forceinline__ void attn_unit(const int tid, int q0, int NT, const bf16* Qh, const bf16* __restrict__ Kh, const bf16* __restrict__ Vh, const bf16* Zh, bf16* Oh, const long PQ, const long PO, char* shm) {
  const int lane = tid & 63, r32 = lane & 31, hi = lane >> 5; const int wid = __builtin_amdgcn_readfirstlane(tid >> 6);
  const bf16* Qw = Qh + (long)(q0 + wid * QBLK) * PQ;
  const unsigned lds0 = (unsigned)(uintptr_t)shm;
  float* wsf = (float*)(shm + LDS_WS) + wid * 64;
  const bf16* ksrc = Kh + (long)lane * PQ + wid * 8;
  const bf16* vsrc = Vh + (long)(16 * (wid & 3) + (lane >> 2)) * PQ + (wid >> 2) * 32 + (lane & 3) * 8;
  const unsigned kdst = lds0 + LDS_K + wid * 1024, vdst = lds0 + LDS_V + wid * 1024;
  #define DMA_K(t, slot) glds16(ksrc + (long)(t) * KVBLK * PQ, (unsigned)__builtin_amdgcn_readfirstlane(kdst + (slot)))
  #define DMA_V(t, slot) glds16(vsrc + (long)(t) * KVBLK * PQ, (unsigned)__builtin_amdgcn_readfirstlane(vdst + (slot)))
  const int vb0 = (int)(lds0 + LDS_V) + ((lane >> 4) & 1) * 32 + (lane & 3) * 8 + (4 * hi + ((lane & 15) >> 2)) * 64;
  const char* Kbase = shm + LDS_K; bf16x8 kf[8];
  const lds_cptr shm3 = (lds_cptr)shm; const lds_cptr kp0 = shm3 + LDS_K + hi * 1024 + r32 * 16; const lds_cptr vp0 = shm3 + LDS_V + ((lane >> 4) & 1) * 32 + (lane & 3) * 8 + (4 * hi + ((lane & 15) >> 2)) * 64;
  DMA_K(0, 0); DMA_V(0, 0); DMA_K(1, SLOTB);
  bf16x8 qr[4];
  #pragma unroll
  for (int d0 = 0; d0 < 4; ++d0) qr[d0] = *reinterpret_cast<const bf16x8*>(&Qw[(long)r32 * PQ + d0 * 16 + hi * 8]);
  float zf_; asm volatile("v_mov_b32 %0, 0" : "=v"(zf_)); f32x16 zv_;
  #pragma unroll
  for (int r = 0; r < 16; ++r) zv_[r] = zf_;
  float mhat = 0.f, l_reg = 0.f; f32x16 o[2]; o[0] = zv_; o[1] = zv_; f32x16 negm = zv_; asm volatile("" : "+v"(negm));
  bool resc = false;
  #define START(P0, P1) do { const float rm = rowmax(P0, P1); resc = false; \
    { const float dl = rm; mhat = fadd_s(mhat, dl); \
      _Pragma("unroll") for (int r = 0; r < 16; ++r) { P0[r] = fsub_s(P0[r], dl); P1[r] = fsub_s(P1[r], dl); } \
      _Pragma("unroll") for (int r = 0; r < 16; ++r) negm[r] = -mhat; asm volatile("" : "+v"(negm)); } \
    _Pragma("unroll") for (int r = 0; r < 16; ++r) P0[r] = __builtin_amdgcn_exp2f(P0[r]); } while (0)
  #define RESC() do { if (resc) { asm volatile("s_waitcnt lgkmcnt(0)" ::: "memory"); \
      _Pragma("unroll") for (int d_ = 0; d_ < 2; ++d_) _Pragma("unroll") for (int r = 0; r < 16; ++r) o[d_][r] *= wsf[crow(r, hi)]; } } while (0)
  f32x16 pA0, pA1, pB0, pB1;
  int sl_prev = 0, sl_cur = 0, sl_next = SLOTB;
  #define ROT() do { sl_prev = sl_cur; sl_cur = sl_next; sl_next = (sl_next == (NSLOT - 1) * SLOTB) ? 0 : sl_next + SLOTB; } while (0)
  DMA_K(2, 2 * SLOTB);
  WAIT_BAR(3);
  qkt(pA0, pA1, Kbase, qr, negm, r32, hi); asm volatile("s_nop 15\n\ts_nop 7" : "+v"(pA0), "+v"(pA1));
  START(pA0, pA1);
  _Pragma("unroll") for (int r = 0; r < 16; ++r) pA1[r] = __builtin_amdgcn_exp2f(pA1[r]);
  WAIT_BAR(0);
  DMA_K(3, 0); DMA_V(1, SLOTB);
  ROT();
  kload8(kf, kp0 + sl_cur);
  WAIT_BAR(2);
  s16x4 vlo[8], vhi[8]; u32x4 pw0, pw1, pw2, pw3;
  #define PKW(P, B) cvtpk_s(P[B], P[B + 1])
  #define PAF(k) __builtin_bit_cast(bf16x8, pw##k)
  #define VFR(i) (bf16x8){vlo[i][0], vlo[i][1], vlo[i][2], vlo[i][3], vhi[i][0], vhi[i][1], vhi[i][2], vhi[i][3]}
  #define PIN(x) asm volatile("" : "+v"(x))
  #define MX3(a, b, c) __builtin_fmaxf(__builtin_fmaxf((a), (b)), (c))
  #define GAPA(MF, A0, A1, A2, A3, W0, W1, PW) do { MF; sacc += A0; sacc += A1; sacc += A2; sacc += A3; PIN(sacc); W0; W1; PIN(PW); SBAR(); } while (0)
  #define EX(v) __builtin_amdgcn_exp2f(v)
  #define GAPB(MF, X, B) do { MF; X[B] = EX(X[B]); X[B + 1] = EX(X[B + 1]); X[B + 2] = EX(X[B + 2]); X[B + 3] = EX(X[B + 3]); PIN(X); SBAR(); } while (0)
  #define VRD(i) do { vlo[i] = vtr(vp_ + (((i) >> 2) * 4096 + ((i) & 3) * 1024)); vhi[i] = vtr(vp_ + (((i) >> 2) * 4096 + ((i) & 3) * 1024 + 512)); } while (0)
  #define KRD(G, j) do { if (G) { kload2(kf, kp0 + sl_next, j); SBAR(); } } while (0)
  #define STEP(C0, C1, P0, P1, t, GK, GV, GL) do { SBAR(); \
    const lds_cptr vp_ = vp0 + sl_prev; \
    VRD(0); SBAR(); float sacc = (P0[0] + P0[1]); \
    GAPA(C0 = __builtin_amdgcn_mfma_f32_32x32x16_bf16(kf[0], qr[0], negm, 0, 0, 0), P0[2], P0[3], P0[4], P0[5],     pw0[0] = PKW(P0, 0), pw0[1] = PKW(P0, 2), pw0); \
    VRD(4); SBAR(); GAPA(C1 = __builtin_amdgcn_mfma_f32_32x32x16_bf16(kf[1], qr[0], negm, 0, 0, 0), P0[6], P0[7], P0[8], P0[9],     pw0[2] = PKW(P0, 4), pw0[3] = PKW(P0, 6), pw0); \
    VRD(1); SBAR(); GAPA(C0 = __builtin_amdgcn_mfma_f32_32x32x16_bf16(kf[2], qr[1], C0, 0, 0, 0),   P0[10], P0[11], P0[12], P0[13], pw1[0] = PKW(P0, 8), pw1[1] = PKW(P0, 10), pw1); \
    VRD(5); SBAR(); GAPA(C1 = __builtin_amdgcn_mfma_f32_32x32x16_bf16(kf[3], qr[1], C1, 0, 0, 0),   P0[14], P0[15], P1[0], P1[1],   pw1[2] = PKW(P0, 12), pw1[3] = PKW(P0, 14), pw1); \
    VRD(2); SBAR(); GAPA(C0 = __builtin_amdgcn_mfma_f32_32x32x16_bf16(kf[4], qr[2], C0, 0, 0, 0),   P1[2], P1[3], P1[4], P1[5],     pw2[0] = PKW(P1, 0), pw2[1] = PKW(P1, 2), pw2); \
    VRD(6); SBAR(); GAPA(C1 = __builtin_amdgcn_mfma_f32_32x32x16_bf16(kf[5], qr[2], C1, 0, 0, 0),   P1[6], P1[7], P1[8], P1[9],     pw2[2] = PKW(P1, 4), pw2[3] = PKW(P1, 6), pw2); \
    VRD(3); SBAR(); GAPA(C0 = __builtin_amdgcn_mfma_f32_32x32x16_bf16(kf[6], qr[3], C0, 0, 0, 0),   P1[10], P1[11], P1[12], P1[13], pw3[0] = PKW(P1, 8), pw3[1] = PKW(P1, 10), pw3); \
    VRD(7); SBAR(); GAPA(C1 = __builtin_amdgcn_mfma_f32_32x32x16_bf16(kf[7], qr[3], C1, 0, 0, 0),   P1[14], P1[15], 0.f, 0.f,       pw3[2] = PKW(P1, 12), pw3[3] = PKW(P1, 14), pw3); \
    l_reg += sacc; \
    if (GK) { DMA_K((t) + 3, sl_cur); } if (GV) { DMA_V((t) + 1, sl_next); } \
    { float a = MX3(C0[0], C0[1], C1[0]), b = MX3(C0[2], C0[3], C1[1]); a = MX3(a, C1[2], C1[3]); \
      _Pragma("unroll") for (int r = 4; r < 16; r += 4) { a = MX3(a, C0[r], C0[r + 1]); b = MX3(b, C0[r + 2], C0[r + 3]); a = MX3(a, C1[r], C1[r + 1]); b = MX3(b, C1[r + 2], C1[r + 3]); } \
      float rm = __builtin_fmaxf(a, b); { auto rr = __builtin_amdgcn_permlane32_swap(__float_as_uint(rm), __float_as_uint(rm), false, false); rm = __builtin_fmaxf(__uint_as_float(rr[0]), __uint_as_float(rr[1])); } \
      resc = false; \
      if (__builtin_expect(__any(rm > (float)THRL), 0)) { const float dl = __builtin_fmaxf(rm, 0.f); mhat += dl; \
        _Pragma("unroll") for (int r = 0; r < 16; ++r) { C0[r] -= dl; C1[r] -= dl; } \
        _Pragma("unroll") for (int r = 0; r < 16; ++r) negm[r] = -mhat; asm volatile("" : "+v"(negm)); \
        const float f = __builtin_amdgcn_exp2f(-dl); l_reg *= f; if (hi == 0) wsf[r32] = f; resc = true; } } \
    SBAR(); \
    GAPB(o[0] = __builtin_amdgcn_mfma_f32_32x32x16_bf16(PAF(0), VFR(0), o[0], 0, 0, 0), C0, 0); \
    GAPB(o[1] = __builtin_amdgcn_mfma_f32_32x32x16_bf16(PAF(0), VFR(4), o[1], 0, 0, 0), C0, 4); \
    KRD(GL, 0); GAPB(o[0] = __builtin_amdgcn_mfma_f32_32x32x16_bf16(PAF(1), VFR(1), o[0], 0, 0, 0), C0, 8); \
    KRD(GL, 1); GAPB(o[1] = __builtin_amdgcn_mfma_f32_32x32x16_bf16(PAF(1), VFR(5), o[1], 0, 0, 0), C0, 12); \
    KRD(GL, 2); GAPB(o[0] = __builtin_amdgcn_mfma_f32_32x32x16_bf16(PAF(2), VFR(2), o[0], 0, 0, 0), C1, 0); \
    KRD(GL, 3); GAPB(o[1] = __builtin_amdgcn_mfma_f32_32x32x16_bf16(PAF(2), VFR(6), o[1], 0, 0, 0), C1, 4); \
    GAPB(o[0] = __builtin_amdgcn_mfma_f32_32x32x16_bf16(PAF(3), VFR(3), o[0], 0, 0, 0), C1, 8); \
    GAPB(o[1] = __builtin_amdgcn_mfma_f32_32x32x16_bf16(PAF(3), VFR(7), o[1], 0, 0, 0), C1, 12); \
    } while (0)
  int t = 1;
  for (; t + 5 < NT; t += 2) {
    STEP(pB0, pB1, pA0, pA1, t, true, true, true);     WAIT_BAR(2); RESC(); ROT();
    STEP(pA0, pA1, pB0, pB1, t + 1, true, true, true); WAIT_BAR(2); RESC(); ROT();
  }
  #define ENDW(tt) do { if ((tt) + 3 < NT) { WAIT_BAR(2); } else if ((tt) + 2 < NT) { WAIT_BAR(1); } else { WAIT_BAR(0); } } while (0)
  for (; t + 1 < NT; t += 2) {
    STEP(pB0, pB1, pA0, pA1, t, (t + 3 < NT), (t + 1 < NT), (t + 1 < NT));         ENDW(t);     RESC(); ROT();
    STEP(pA0, pA1, pB0, pB1, t + 1, (t + 4 < NT), (t + 2 < NT), (t + 2 < NT));     ENDW(t + 1); RESC(); ROT();
  }
  STEP(pB0, pB1, pA0, pA1, NT - 1, false, false, false); RESC();
  { float sacc = pB0[0] + pB0[1]; _Pragma("unroll") for (int r = 2; r < 16; ++r) sacc += pB0[r]; _Pragma("unroll") for (int r = 0; r < 16; ++r) sacc += pB1[r]; l_reg += sacc;
    pw0 = (u32x4){PKW(pB0, 0), PKW(pB0, 2), PKW(pB0, 4), PKW(pB0, 6)}; pw1 = (u32x4){PKW(pB0, 8), PKW(pB0, 10), PKW(pB0, 12), PKW(pB0, 14)}; pw2 = (u32x4){PKW(pB1, 0), PKW(pB1, 2), PKW(pB1, 4), PKW(pB1, 6)}; pw3 = (u32x4){PKW(pB1, 8), PKW(pB1, 10), PKW(pB1, 12), PKW(pB1, 14)};
    SBAR(); pv(o, vb0 + sl_cur, PAF(0), PAF(1), PAF(2), PAF(3)); }
  #undef PKW
  #undef PAF
  #undef VFR
  #undef PIN
  #undef MX3
  #undef GAPA
  #undef GAPB
  #undef EX
  #undef VRD
  #undef KRD
  #undef STEP
  #undef ENDW
  { auto rr = __builtin_amdgcn_permlane32_swap(__float_as_uint(l_reg), __float_as_uint(l_reg), false, false); l_reg = __uint_as_float(rr[0]) + __uint_as_float(rr[1]); }
  if (hi == 0) wsf[32 + r32] = l_reg; asm volatile("s_waitcnt lgkmcnt(0)" ::: "memory");
  float rli[16];
  #pragma unroll
  for (int r = 0; r < 16; ++r) rli[r] = __builtin_amdgcn_rcpf(wsf[32 + crow(r, hi)]);
  bf16* Ow = Oh + (long)(q0 + wid * QBLK) * PO;
  const bf16* Zw = Zh + (long)(q0 + wid * QBLK) * PQ;
  { bf16* stg = (bf16*)(shm + LDS_OST) + wid * 2048;
    #pragma unroll
    for (int r = 0; r < 16; ++r) { const int orow = crow(r, hi);
      #pragma unroll
      for (int d0 = 0; d0 < 2; ++d0) stg[orow * 64 + d0 * 32 + r32] = __float2bfloat16(o[d0][r] * rli[r]); }
    asm volatile("s_waitcnt lgkmcnt(0)" ::: "memory");
    #pragma unroll
    for (int i = 0; i < 4; ++i) { const int row = i * 8 + (lane >> 3), ch = lane & 7; const u32x4 v = *(const u32x4*)(stg + row * 64 + ch * 8);
      const u32x4 z = *(const u32x4*)(Zw + (long)row * PQ + ch * 8); u32x4 w;
      #pragma unroll
      for (int e = 0; e < 4; ++e) w[e] = cvt_pk_bf16(bf_lo(v[e]) * silu_f(bf_lo(z[e])), bf_hi(v[e]) * silu_f(bf_hi(z[e])));
      *(u32x4*)(Ow + (long)row * PO + ch * 8) = w; } }
  asm volatile("s_waitcnt lgkmcnt(0)\n\ts_barrier" ::: "memory");
  #undef DMA_K
  #undef DMA_V
  #undef START
  #undef RESC
  #undef ROT
}
#undef WAIT_BAR
}

struct LA { f32x16 o0, o1; float m, l; };
__device__ __forceinline__ f32x16 zero16() { float z; asm volatile("v_mov_b32 %0, 0" : "=v"(z)); f32x16 v;
#pragma unroll
    for (int r = 0; r < 16; ++r) v[r] = z;
    return v; }
struct Frag { bf16x8 k[4], v[4]; };
struct TP { unsigned koff, voff; const LAS char* tp; int cb; const LAS char* tp2; };
__device__ __forceinline__ void la_loadK(Frag& f, const char* kb, const TP& t) {
#pragma unroll
    for (int d0 = 0; d0 < 4; ++d0) f.k[d0] = *(const bf16x8*)(kb + t.koff + d0 * 32);
}
struct VSG { const char* b;
    template <int V1> __device__ __forceinline__ void load(Frag& f, unsigned voff) const { const char* p = b + (long)(int)voff; const char* q = p + (size_t)16 * VTPP * 2;
        f.v[0] = *(const bf16x8*)(p); f.v[1] = *(const bf16x8*)(p + V1); f.v[2] = *(const bf16x8*)(q); f.v[3] = *(const bf16x8*)(q + V1); } };
constexpr int VSL_PITCH = 1296;
struct VSL { const LAS char* b;
    template <int V1> __device__ __forceinline__ void load(Frag& f, unsigned voff) const { const LAS char* p = b + voff; const LAS char* q = p + 32 * VSL_PITCH;
        f.v[0] = *(const LAS bf16x8*)(p); f.v[1] = *(const LAS bf16x8*)(p + V1); f.v[2] = *(const LAS bf16x8*)(q); f.v[3] = *(const LAS bf16x8*)(q + V1); } };
template <int TS4, int TG4> struct MBTab {
    __device__ __forceinline__ static float apply(const TP& t, int reg, float s) { return s + *(const LAS float*)(t.tp + (reg & 7) * TS4 + (reg >> 3) * TG4); }
    __device__ __forceinline__ static TP second(const TP& t) { TP b = t; b.tp = t.tp2; return b; }
};
template <int GI4, int GC> struct MBNa {
    __device__ __forceinline__ static float apply(const TP& t, int reg, float s) { const float b = *(const LAS float*)(t.tp + (reg & 7) * 4 + (reg >> 3) * GI4);
        return (unsigned)(t.cb + (reg & 7) + (reg >> 3) * GC) < 16u ? s + b : NEGBIG; }
    __device__ __forceinline__ static TP second(const TP& t) { TP b = t; b.tp = t.tp2; return b; }
};
template <int GI4> struct MBNaXM {
    __device__ __forceinline__ static float apply(const TP& t, int reg, float s) { const float b = *(const LAS float*)(t.tp + (reg & 7) * 4 + (reg >> 3) * GI4);
        const bool col = (unsigned)((int)(short)(t.cb & 0xffff) + (reg & 7)) < 16u, row = (t.cb >> (reg < 8 ? 16 : 17)) & 1; return (col && row) ? s + b : NEGBIG; }
    __device__ __forceinline__ static TP second(const TP& t) { TP b = t; b.tp = t.tp2; b.cb = (t.cb & 0xffff) | ((t.cb >> 4) & 0x30000); return b; }
};
template <class MB, int V1, class VS> __device__ __forceinline__ void la_step(LA& st, const bf16x8 (&qf)[4], Frag& f, const char* kb, const VS& vs, const TP& t, const TP& n) {
    f32x16 s = zero16();
#pragma unroll
    for (int d0 = 0; d0 < 4; ++d0) s = __builtin_amdgcn_mfma_f32_32x32x16_bf16(f.k[d0], qf[d0], s, 0, 0, 0);
    la_loadK(f, kb, n);
    float mx = NEGBIG;
#pragma unroll
    for (int r = 0; r < 16; ++r) { s[r] = MB::apply(t, r, s[r]); mx = __builtin_fmaxf(mx, s[r]); }
    { auto rr = __builtin_amdgcn_permlane32_swap(__float_as_uint(mx), __float_as_uint(mx), false, false); mx = __builtin_fmaxf(__uint_as_float(rr[0]), __uint_as_float(rr[1])); }
    if (__any(mx > st.m)) { const float mn = __builtin_fmaxf(st.m, mx), alpha = __builtin_amdgcn_exp2f(st.m - mn); st.m = mn; st.l *= alpha; st.o0 *= alpha; st.o1 *= alpha; }
    float rs = 0.f;
#pragma unroll
    for (int r = 0; r < 16; ++r) { s[r] = __builtin_amdgcn_exp2f(s[r] - st.m); rs += s[r]; }
    st.l += rs;
    u32x4 p0, p1;
#pragma unroll
    for (int e = 0; e < 4; ++e) { p0[e] = cvt_pk_bf16(s[2 * e], s[2 * e + 1]); p1[e] = cvt_pk_bf16(s[8 + 2 * e], s[8 + 2 * e + 1]); }
    const bf16x8 pf0 = __builtin_bit_cast(bf16x8, p0), pf1 = __builtin_bit_cast(bf16x8, p1);
    st.o0 = __builtin_amdgcn_mfma_f32_32x32x16_bf16(f.v[0], pf0, st.o0, 0, 0, 0); st.o0 = __builtin_amdgcn_mfma_f32_32x32x16_bf16(f.v[1], pf1, st.o0, 0, 0, 0);
    st.o1 = __builtin_amdgcn_mfma_f32_32x32x16_bf16(f.v[2], pf0, st.o1, 0, 0, 0); st.o1 = __builtin_amdgcn_mfma_f32_32x32x16_bf16(f.v[3], pf1, st.o1, 0, 0, 0);
    vs.template load<V1>(f, n.voff);
}
template <int TS4, int TG4> struct MBTabM {
    __device__ __forceinline__ static float apply(const TP& t, int reg, float s) { const float v = s + *(const LAS float*)(t.tp + (reg & 7) * TS4 + (reg >> 3) * TG4);
        return (t.cb & (reg < 8 ? 1 : 2)) ? NEGBIG : v; }
    __device__ __forceinline__ static TP second(const TP& t) { TP b = t; b.tp = t.tp2; return b; }
};
typedef MBTabM<64, 1024> MB_D4M;
typedef MBTab<64, 8> MB_D1; typedef MBTab<4, 64> MB_A; typedef MBNa<64, 16> MB_B; typedef MBNa<1024, 0> MB_BX; typedef MBNaXM<1024> MB_BXM; typedef MBTab<64, 1024> MB_D16; typedef MBTab<64, 32> MB_D4;
#define LA_RUN(NT, TILE, MB, V1, KB, VS_) do { Frag f_; { const TP t0_ = TILE(0); la_loadK(f_, KB, t0_); (VS_).template load<V1>(f_, t0_.voff); } \
    _Pragma("unroll 1") for (int i_ = 0; i_ < (NT); ++i_) { const TP t_ = TILE(i_); const TP n_ = TILE(i_ + 1 < (NT) ? i_ + 1 : i_); la_step<MB, V1>(st, qf, f_, KB, VS_, t_, n_); } } while (0)
template <class MB> __device__ __forceinline__ void la_soft(LA& st, f32x16& s, const TP& t, bf16x8& pf0, bf16x8& pf1) {
    float mx = NEGBIG;
#pragma unroll
    for (int r = 0; r < 16; ++r) { s[r] = MB::apply(t, r, s[r]); mx = __builtin_fmaxf(mx, s[r]); }
    { auto rr = __builtin_amdgcn_permlane32_swap(__float_as_uint(mx), __float_as_uint(mx), false, false); mx = __builtin_fmaxf(__uint_as_float(rr[0]), __uint_as_float(rr[1])); }
    if (__any(mx > st.m)) { const float mn = __builtin_fmaxf(st.m, mx), alpha = __builtin_amdgcn_exp2f(st.m - mn); st.m = mn; st.l *= alpha; st.o0 *= alpha; st.o1 *= alpha; }
    float rs = 0.f;
#pragma unroll
    for (int r = 0; r < 16; ++r) { s[r] = __builtin_amdgcn_exp2f(s[r] - st.m); rs += s[r]; }
    st.l += rs;
    u32x4 p0, p1;
#pragma unroll
    for (int e = 0; e < 4; ++e) { p0[e] = cvt_pk_bf16(s[2 * e], s[2 * e + 1]); p1[e] = cvt_pk_bf16(s[8 + 2 * e], s[8 + 2 * e + 1]); }
    pf0 = __builtin_bit_cast(bf16x8, p0); pf1 = __builtin_bit_cast(bf16x8, p1);
}
template <class MB, int V1, class VS> __device__ __forceinline__ void la_step2(LA& sa, LA& sb, const bf16x8 (&qa)[4], const bf16x8 (&qb)[4], Frag& f, const char* kb, const VS& vs, const TP& t, const TP& n) {
    bf16x8 pa0, pa1;
    { f32x16 s0 = zero16();
#pragma unroll
      for (int d0 = 0; d0 < 4; ++d0) s0 = __builtin_amdgcn_mfma_f32_32x32x16_bf16(f.k[d0], qa[d0], s0, 0, 0, 0);
      la_soft<MB>(sa, s0, t, pa0, pa1); }
    f32x16 s1 = zero16();
#pragma unroll
    for (int d0 = 0; d0 < 4; ++d0) s1 = __builtin_amdgcn_mfma_f32_32x32x16_bf16(f.k[d0], qb[d0], s1, 0, 0, 0);
    la_loadK(f, kb, n);
    sa.o0 = __builtin_amdgcn_mfma_f32_32x32x16_bf16(f.v[0], pa0, sa.o0, 0, 0, 0); sa.o1 = __builtin_amdgcn_mfma_f32_32x32x16_bf16(f.v[2], pa0, sa.o1, 0, 0, 0);
    sa.o0 = __builtin_amdgcn_mfma_f32_32x32x16_bf16(f.v[1], pa1, sa.o0, 0, 0, 0); sa.o1 = __builtin_amdgcn_mfma_f32_32x32x16_bf16(f.v[3], pa1, sa.o1, 0, 0, 0);
    { bf16x8 pb0, pb1; const TP tb = MB::second(t);
      la_soft<MB>(sb, s1, tb, pb0, pb1);
      sb.o0 = __builtin_amdgcn_mfma_f32_32x32x16_bf16(f.v[0], pb0, sb.o0, 0, 0, 0); sb.o1 = __builtin_amdgcn_mfma_f32_32x32x16_bf16(f.v[2], pb0, sb.o1, 0, 0, 0);
      sb.o0 = __builtin_amdgcn_mfma_f32_32x32x16_bf16(f.v[1], pb1, sb.o0, 0, 0, 0); sb.o1 = __builtin_amdgcn_mfma_f32_32x32x16_bf16(f.v[3], pb1, sb.o1, 0, 0, 0); }
    vs.template load<V1>(f, n.voff);
}
#define LA_RUN2(NT, TILE, MB, V1, KB, VS_) do { Frag f_; { const TP t0_ = TILE(0); la_loadK(f_, KB, t0_); (VS_).template load<V1>(f_, t0_.voff); } \
    _Pragma("unroll 1") for (int i_ = 0; i_ < (NT); ++i_) { const TP t_ = TILE(i_); const TP n_ = TILE(i_ + 1 < (NT) ? i_ + 1 : i_); la_step2<MB, V1>(sa, sb, qa, qb, f_, KB, VS_, t_, n_); } } while (0)
__device__ __forceinline__ int o1_off(int rho, int ch) { return rho * 128 + (((ch + (rho >> 1) + (rho >> 4)) & 15) << 3); }

__device__ __forceinline__ int lam_of(int r32) { return (r32 & 0x13) | ((r32 & 4) << 1) | ((r32 & 8) >> 1); }

__device__ __forceinline__ void la_loadz(u32x2 (&z)[8], const bf16_t* zrow, int hi) {
#pragma unroll
    for (int db = 0; db < 2; ++db)
#pragma unroll
        for (int g = 0; g < 4; ++g) z[4 * db + g] = *(const u32x2*)(zrow + 32 * db + 8 * g + 4 * hi);
}
__device__ __forceinline__ void la_store(const LA& st, bool use_sink, float sink2, const u32x2 (&zv)[8], bf16_t* yrow, int hi) {
    float l = st.l; { auto rr = __builtin_amdgcn_permlane32_swap(__float_as_uint(l), __float_as_uint(l), false, false); l = __uint_as_float(rr[0]) + __uint_as_float(rr[1]); }
    float inv;
    if (use_sink) { const float m2 = fmaxf(st.m, sink2), a = __builtin_amdgcn_exp2f(st.m - m2); inv = a / (l * a + __builtin_amdgcn_exp2f(sink2 - m2)); }
    else inv = 1.f / l;
#pragma unroll
    for (int db = 0; db < 2; ++db)
#pragma unroll
        for (int g = 0; g < 4; ++g) { const int c = 32 * db + 8 * g + 4 * hi; const u32x2 z = zv[4 * db + g];
            const f32x16& o = db ? st.o1 : st.o0;
            u32x2 w; w.x = cvt_pk_bf16(o[4 * g] * inv * silu_f(bf_lo(z.x)), o[4 * g + 1] * inv * silu_f(bf_hi(z.x)));
            w.y = cvt_pk_bf16(o[4 * g + 2] * inv * silu_f(bf_lo(z.y)), o[4 * g + 3] * inv * silu_f(bf_hi(z.y)));
            *(u32x2*)(yrow + c) = w; }
}

#define XB_TMO      128
#define XB_XCNT(j)  (256  + 64 * (j))
#define XB_XSUB(j)  (1280 + 64 * (j))
#define XB_XGEN(j)  (2304 + 64 * (j))
#define XB_TOP      3328
#define XB_TOPGEN   3392
#define XCD_BAR_WORDS 3456
#define XB_SPIN_CAP (1u << 18)

__device__ __forceinline__ unsigned xb_ld(unsigned* p)              { return __hip_atomic_load(p, __ATOMIC_RELAXED, __HIP_MEMORY_SCOPE_AGENT); }
__device__ __forceinline__ unsigned xb_add(unsigned* p, unsigned v) { return __hip_atomic_fetch_add(p, v, __ATOMIC_RELAXED, __HIP_MEMORY_SCOPE_AGENT); }
__device__ __forceinline__ unsigned xb_xcc_id() { return (unsigned)__builtin_amdgcn_s_getreg((3 << 11) | 20) & 0xFu; }
#define XB_SPIN(cond, bar) do { unsigned _sp = 0; while (cond) { __builtin_amdgcn_s_sleep(1); \
    if ((++_sp & 255u) == 0u) { if (xb_ld(&(bar)[XB_TMO])) break; if (_sp > XB_SPIN_CAP) { atomicAdd(&(bar)[XB_TMO], 1u); break; } } } } while (0)

__device__ __forceinline__ unsigned xb_lane() { return __builtin_amdgcn_mbcnt_hi(~0u, __builtin_amdgcn_mbcnt_lo(~0u, 0u)); }
struct XcdBarrier {
    unsigned* bar; unsigned x; unsigned lead;
    volatile LAS unsigned* st;
};

__device__ __forceinline__ XcdBarrier xcd_barrier_post(unsigned* bar, volatile LAS unsigned* st, unsigned lead) {
    XcdBarrier b; b.bar = bar; b.x = xb_xcc_id(); b.st = st; b.lead = lead;
    if (lead != 0u && xb_lane() == 0u) (void)xb_add(&bar[XB_XCNT(b.x)], 1u);
    return b;
}
__device__ __forceinline__ void xcd_barrier_complete(unsigned* bar, unsigned x, unsigned& nloc, unsigned& nx) {
    const unsigned G = gridDim.x * gridDim.y * gridDim.z;
    unsigned sum, cnt, mine, sp = 0u;
    for (;;) {
        sum = 0u; cnt = 0u; mine = 0u;
#pragma unroll
        for (unsigned j = 0; j < 16; ++j) { const unsigned c = xb_ld(&bar[XB_XCNT(j)]); sum += c; cnt += (c > 0u) ? 1u : 0u; mine = (j == x) ? c : mine; }
        if (sum == G) break;
        __builtin_amdgcn_s_sleep(1);
        if ((++sp & 255u) == 0u) { if (xb_ld(&bar[XB_TMO])) break; if (sp > XB_SPIN_CAP) { atomicAdd(&bar[XB_TMO], 1u); break; } }
    }
    nloc = mine > 0u ? mine : 1u; nx = cnt > 0u ? cnt : 1u;
}

__device__ __forceinline__ void xcd_barrier(const XcdBarrier& b) {
    asm volatile("s_waitcnt vmcnt(0)" ::: "memory");
    __syncthreads();
    if (b.lead != 0u && xb_lane() == 0u) {
        unsigned* bar = b.bar;
        __builtin_amdgcn_s_waitcnt(0);
        unsigned nloc = b.st[0], nx = b.st[1];
        if (nloc == 0u) { xcd_barrier_complete(bar, b.x, nloc, nx); b.st[0] = nloc; b.st[1] = nx; }
        const unsigned old = xb_add(&bar[XB_XSUB(b.x)], 1u);
        const unsigned gen = old / nloc;
        if (old + 1u == (gen + 1u) * nloc) {
            __builtin_amdgcn_fence(__ATOMIC_RELEASE, "agent");
            asm volatile("s_waitcnt vmcnt(0)" ::: "memory");
            const unsigned og = xb_add(&bar[XB_TOP], 1u);
            const unsigned tg = og / nx;
            if (og + 1u == (tg + 1u) * nx) xb_add(&bar[XB_TOPGEN], 1u);
            else XB_SPIN(xb_ld(&bar[XB_TOPGEN]) == tg, bar);
            __builtin_amdgcn_fence(__ATOMIC_ACQUIRE, "agent");
            xb_add(&bar[XB_XGEN(b.x)], 1u);
            asm volatile("s_waitcnt vmcnt(0)" ::: "memory");
        } else {
            XB_SPIN(xb_ld(&bar[XB_XGEN(b.x)]) == gen, bar);
            __builtin_amdgcn_fence(__ATOMIC_ACQUIRE, "agent");
            asm volatile("s_waitcnt vmcnt(0)" ::: "memory");
        }
    }
    __syncthreads();
}

__device__ __forceinline__ void convert_items(const float* W, bf16_t* WT, const int N, const int permute, LAS float* scr, const int lane, const int first, const int stride, const int nitems) {
    for (int item = first; item < nitems; item += stride) {
        const int nblk = N / 32, kb = item / nblk, nb = item % nblk, k0 = 64 * kb, n0 = 32 * nb;
        int d0 = n0;
        if (permute && n0 >= 13 * 256 && n0 < 16 * 256) { const int o = n0 & 255, wc = o >> 6, bj = (o >> 5) & 1; d0 = (n0 & ~255) + 128 * bj + 32 * wc; }
        { float tv[32];
#pragma unroll
        for (int i = 0; i < 32; ++i) { const int kk = 2 * i + (lane >> 5); tv[i] = __builtin_nontemporal_load(W + (size_t)(k0 + kk) * N + n0 + (lane & 31)); }
#pragma unroll
        for (int i = 0; i < 32; ++i) { const int kk = 2 * i + (lane >> 5); scr[kk * 33 + (lane & 31)] = tv[i]; } }
        asm volatile("s_waitcnt lgkmcnt(0)" ::: "memory");
        const int c = lane & 7;
#pragma unroll
        for (int j = 0; j < 4; ++j) { const int n = (lane >> 3) + 8 * j; const LAS float* s = scr + (8 * c) * 33 + n;
            u32x4 o; o.x = cvt_pk_bf16(s[0 * 33], s[1 * 33]); o.y = cvt_pk_bf16(s[2 * 33], s[3 * 33]); o.z = cvt_pk_bf16(s[4 * 33], s[5 * 33]); o.w = cvt_pk_bf16(s[6 * 33], s[7 * 33]);
            *(u32x4*)(WT + (size_t)(d0 + n) * DMODEL + k0 + 8 * c) = o; }
        asm volatile("s_waitcnt lgkmcnt(0)" ::: "memory");
    }
}
struct Args { const float* in[13]; float* out; unsigned char* ws; int ph_lo, ph_hi; };

__global__ void __launch_bounds__(NWAVES * 64, 2) mk_fwd(Args args) {
    extern __shared__ __attribute__((aligned(16))) unsigned char lds_raw[];
    LAS unsigned char* lds = (LAS unsigned char*)lds_raw;
    const int G = gridDim.x;
#define PHASE_BEGIN \
    int tid = wave_s * 64 + (int)xb_lane(); asm volatile("" : "+v"(tid)); int bx = blockIdx.x; asm volatile("" : "+s"(bx)); \
    const int lane = tid & 63, wave = __builtin_amdgcn_readfirstlane(tid >> 6); \
    const int vcu = (G % 8 == 0) ? (bx % 8) * (G / 8) + bx / 8 : bx; const int gw = vcu * NWAVES + wave, NGW = G * NWAVES; \
    size_t zoff_ = 0; asm volatile("" : "+s"(zoff_)); unsigned char* ws = args.ws + zoff_; \
    const Args* ka_ = (const Args*)((const char*)__builtin_amdgcn_kernarg_segment_ptr() + zoff_); \
    const float* x_in = ka_->in[0]; const float* c_in = ka_->in[1]; const float* w_ada = ka_->in[2]; const float* b_ada = ka_->in[3]; const float* norm_w = ka_->in[4]; \
    const float* w_in = ka_->in[5]; const float* w_out = ka_->in[6]; const float* attn_sink = ka_->in[7]; const float* na_rpb = ka_->in[8]; \
    const float* q_norm_w = ka_->in[9]; const float* k_norm_w = ka_->in[10]; const float* t5_table = ka_->in[11]; const float* final_norm_w = ka_->in[12]; float* out_p = ka_->out; \
    (void)x_in; (void)c_in; (void)w_ada; (void)b_ada; (void)norm_w; (void)w_in; (void)w_out; (void)attn_sink; (void)na_rpb; (void)q_norm_w; (void)k_norm_w; (void)t5_table; (void)final_norm_w; (void)out_p; \
    float* MODV = (float*)(ws + WS_MODV); float* TABA = (float*)(ws + WS_TABA); float* TABD = (float*)(ws + WS_TABD); float* CS = (float*)(ws + WS_CS); \
    bf16_t* WINT = (bf16_t*)(ws + WS_WINT); bf16_t* WOUTT = (bf16_t*)(ws + WS_WOUTT); bf16_t* Hb = (bf16_t*)(ws + WS_H); bf16_t* PROJ = (bf16_t*)(ws + WS_PROJ); \
    bf16_t* VTA = (bf16_t*)(ws + WS_VTA); bf16_t* VTB = (bf16_t*)(ws + WS_VTB); bf16_t* VTD = (bf16_t*)(ws + WS_VTD); bf16_t* Yb = (bf16_t*)(ws + WS_Y); float* XR = (float*)(ws + WS_XR); \
    (void)lane; (void)wave; (void)gw; (void)NGW; (void)MODV; (void)TABA; (void)TABD; (void)CS; (void)WINT; (void)WOUTT; (void)Hb; (void)PROJ; (void)VTA; (void)VTB; (void)VTD; (void)Yb; (void)XR;
    const int lo = args.ph_lo, hi_ph = args.ph_hi;
#define IN(k) (lo <= (k) && (k) < hi_ph)
    volatile LAS unsigned* bst = (volatile LAS unsigned*)(lds + 131072 + 64);
    const int wave_s = __builtin_amdgcn_readfirstlane((int)threadIdx.x >> 6);
    if (threadIdx.x < 2) bst[threadIdx.x] = 0u;
    __syncthreads();
    const bool one_launch = (lo == 0 && hi_ph == 18);
    XcdBarrier xbar; xbar.bar = (unsigned*)args.ws; xbar.x = 0; xbar.st = bst; xbar.lead = (wave_s == 0) ? 1u : 0u;
    if (one_launch) xbar = xcd_barrier_post((unsigned*)args.ws, bst, (wave_s == 0) ? 1u : 0u);
#define SEAM(k) do { if (IN(k) && IN((k) + 1)) { if (hi_ph > 1000) cg::this_grid().sync(); else { XcdBarrier xb_ = xbar; unsigned x_ = __builtin_amdgcn_readfirstlane(xb_.x), l_ = __builtin_amdgcn_readfirstlane(xb_.lead); asm volatile("" : "+s"(x_), "+s"(l_)); xb_.x = x_; xb_.lead = l_; xcd_barrier(xb_); } } } while (0)

    if (IN(0)) {
        PHASE_BEGIN
        {
            constexpr int I_IN = (DMODEL / 64) * (NIN / 32);
            convert_items(w_in, WINT, NIN, 1, (LAS float*)(lds + wave * 16384), lane, gw, NGW, I_IN);
        }
        __syncthreads();
        {
            LAS float* cond = (LAS float*)lds; LAS float* red = cond + 2048;
            for (int i = tid; i < 2048; i += 512) cond[i] = silu_f(c_in[i]);
            __syncthreads();
            for (int it = vcu; it < DEPTH * 192; it += G) { const int l = it / 192, c0 = (it % 192) * 32;
                const int cq = lane & 7, rsub = lane >> 3;
                const float* wp = w_ada + (size_t)l * DMODEL * 6144 + c0 + 4 * cq + (size_t)(8 * wave + rsub) * 6144;
                f32x4 a0 = (f32x4){0.f, 0.f, 0.f, 0.f}, a1 = a0;
#pragma unroll 1
                for (int j = 0; j < 32; j += 16) {
                    f32x4 wv[16];
#pragma unroll
                    for (int q = 0; q < 16; ++q) wv[q] = __builtin_nontemporal_load((const f32x4*)(wp + (size_t)(64 * (j + q)) * 6144));
#pragma unroll
                    for (int q = 0; q < 16; q += 2) { a0 += wv[q] * cond[64 * (j + q) + 8 * wave + rsub]; a1 += wv[q + 1] * cond[64 * (j + q + 1) + 8 * wave + rsub]; }
                }
                a0 += a1;
#pragma unroll
                for (int e = 0; e < 4; ++e) { float v = a0[e]; v += __shfl_xor(v, 8); v += __shfl_xor(v, 16); v += __shfl_xor(v, 32); a0[e] = v; }
                if (lane < 8) *(LAS f32x4*)(red + wave * 32 + 4 * lane) = a0;
                __syncthreads();
                if (tid < 32) { float s_ = b_ada[l * 6144 + c0 + tid];
#pragma unroll
                    for (int p = 0; p < 8; ++p) s_ += red[p * 32 + tid];
                    MODV[l * 6144 + c0 + tid] = s_; }
                __syncthreads();
            }
        }
        { const int gt = vcu * 512 + tid, NT_ = G * 512;
            for (int i = gt; i < SEQ * 32; i += NT_) { const int t = i >> 5, p = i & 31; const int fi = p & 15; const float pos = (p < 16) ? (float)(t >> 6) : (float)(t & 63);
                const float inv = powf(10000.f, -(float)(2 * fi) / 32.f); const float ang = pos * inv; float sn, cs; sincosf(ang, &sn, &cs); CS[2 * i] = cs; CS[2 * i + 1] = sn; }
            for (int i = gt; i < 8 * TABA_N + 8 * TABD_N; i += NT_) {
                int h, rel; float* dst;
                if (i < 8 * TABA_N) { h = i / TABA_N; rel = i % TABA_N - TABA_C; dst = TABA + i; } else { const int j = i - 8 * TABA_N; h = 8 + j / TABD_N; rel = j % TABD_N - TABD_C; dst = TABD + j; }
                const int n = rel < 0 ? -rel : rel; const float xf = (float)(n > 8 ? n : 8) / 8.f;
                int big = 8 + (int)(logf(xf) / 4.852030263919617f * 8.f); big = big < 15 ? big : 15;
                const int bucket = (rel > 0 ? 16 : 0) + (n < 8 ? n : big);
                *dst = t5_table[bucket * 16 + h] * LOG2E; }
        }
    }
    SEAM(0);

#pragma unroll 1
    for (int l = 0; l < DEPTH; ++l) {
        const int pb = 1 + 4 * l;
        if (IN(pb)) {
            PHASE_BEGIN
            const float* xcur = (l == 0) ? x_in : XR;
            LAS float* gL = (LAS float*)lds; LAS float* sL = gL + 2048;
            for (int i = tid; i < 2048; i += 512) { gL[i] = norm_w[l * 2048 + i] * (1.f + MODV[l * 6144 + 2048 + i]); sL[i] = MODV[l * 6144 + i]; }
            __syncthreads();
            for (int m = gw; m < SEQ; m += NGW) {
                const f32x4* xr = (const f32x4*)(xcur + (size_t)m * DMODEL) + lane;
                f32x4 v[8]; float s = 0.f;
#pragma unroll
                for (int j = 0; j < 8; ++j) { v[j] = xr[64 * j]; s += (v[j][0] * v[j][0] + v[j][1] * v[j][1]) + (v[j][2] * v[j][2] + v[j][3] * v[j][3]); }
                const float rstd = __builtin_amdgcn_rsqf(wave_sum(s) * (1.f / DMODEL) + EPS);
                u32x2* o8 = (u32x2*)(Hb + (size_t)m * DMODEL) + lane;
#pragma unroll
                for (int j = 0; j < 8; ++j) { const f32x4 g = *(const LAS f32x4*)(gL + 4 * lane + 256 * j), sh = *(const LAS f32x4*)(sL + 4 * lane + 256 * j);
                    const f32x4 y = v[j] * rstd * g + sh; u32x2 w; w.x = cvt_pk_bf16(y[0], y[1]); w.y = cvt_pk_bf16(y[2], y[3]); o8[64 * j] = w; }
            }
            __syncthreads();
        }
        SEAM(pb);
        if (IN(pb + 1)) {
            PHASE_BEGIN
            pg8::SchedIn S{(const char*)Hb, (const char*)(WINT + (size_t)l * NIN * DMODEL), G, bx};
            pg8::EpiIn E{PROJ, VTA, VTB, VTD, CS, q_norm_w + l * 64, k_norm_w + l * 64};
            pg8::gemm_phase<pg8::EpiIn, pg8::SchedIn>(tid, lds, DMODEL, S, E);
            const int first_idle = 1728 - 6 * G;
            if (G == 256 ? (bx >= first_idle) : true) {
                const int nidle = (G == 256) ? (G - first_idle) : G, me = (G == 256) ? (bx - first_idle) : bx;
                LAS float* scr = (LAS float*)(lds + wave * 16384);
                constexpr int I_IN = (DMODEL / 64) * (NIN / 32), I_OUT = (DMODEL / 64) * (DMODEL / 32);
                convert_items(w_out + (size_t)l * DMODEL * DMODEL, WOUTT + (size_t)l * DMODEL * DMODEL, DMODEL, 0, scr, lane, me * NWAVES + wave, nidle * NWAVES, I_OUT);
                if (l + 1 < DEPTH) convert_items(w_in + (size_t)(l + 1) * DMODEL * NIN, WINT + (size_t)(l + 1) * NIN * DMODEL, NIN, 1, scr, lane, me * NWAVES + wave, nidle * NWAVES, I_IN);
            }
        }
        SEAM(pb + 1);
        if (IN(pb + 2)) {
            PHASE_BEGIN
            {
                const int h = vcu >> 5;
                for (int u = 0; u < 2; ++u) { const int qb = (vcu & 31) * 2 + u;
                    attn_body::attn_unit<8>(tid, qb * 256, SEQ / 64, (const attn_body::bf16*)(PROJ + C_QC + h * 64), (const attn_body::bf16*)(PROJ + C_KC + (h >> 2) * 64), (const attn_body::bf16*)(PROJ + C_VC + (h >> 2) * 64),
                                            (const attn_body::bf16*)(PROJ + C_ZC + h * 64), (attn_body::bf16*)(Yb + 1024 + h * 64), (long)PP, (long)DMODEL, (char*)lds_raw); }
            }
            __syncthreads();
        }
        if (IN(pb + 2)) {
            PHASE_BEGIN
            const int h = vcu >> 5, v32 = vcu & 31;
            LAS float* tabA = (LAS float*)lds; LAS float* tabD1 = tabA + TABA_N; LAS float* tabD4 = tabD1 + TABA_N; LAS float* tabD16 = tabD4 + 2052; LAS float* tabNEG = tabD16 + 3076; LAS float* tabB = tabNEG + 512;
            LAS unsigned char* VIM = lds + 36864;
            LAS unsigned char* O1 = VIM; LAS float* LSE1 = (LAS float*)(VIM + 65536);
            {
                float vA = 0.f, vD1 = 0.f, v4[5], v16[7], vB[4]; u32x4 wv[12];
                if (tid < TABA_N) { const int rel = tid - TABA_C; vA = TABA[h * TABA_N + tid]; vD1 = TABD[h * TABD_N + TABD_C + rel]; }
#pragma unroll
                for (int k = 0; k < 5; ++k) { const int i = tid + 512 * k; v4[k] = (i < 2049) ? TABD[h * TABD_N + TABD_C + i - 1024] : 0.f; }
#pragma unroll
                for (int k = 0; k < 7; ++k) { const int i = tid + 512 * k; v16[k] = (i < TABD_N) ? TABD[h * TABD_N + i] : 0.f; }
#pragma unroll
                for (int k = 0; k < 4; ++k) { const int i = tid + 512 * k; const int r = i >> 7, c = (i & 127) - 64 + 15; vB[k] = (i < 15 * 128 && c >= 0 && c < 31) ? na_rpb[((l * 8 + h) * 15 + r) * 31 + c] * LOG2E : 0.f; }
#pragma unroll
                for (int k = 0; k < 12; ++k) { const int p = tid + 512 * k; const int pc = p % 6, c = (p / 6) & 15, d = p / 96; const int s8 = 32 * v32 - 8 + 8 * pc;
                    wv[k] = (u32x4){0u, 0u, 0u, 0u}; if (s8 >= 0 && s8 < 1024) wv[k] = *(const u32x4*)(VTD + vt_off(h * 64 + d, c * 1024 + s8)); }
                if (tid < TABA_N) { const int rel = tid - TABA_C; tabA[tid] = (rel >= -128 && rel <= 128) ? vA : NEGBIG; tabD1[tid] = (rel >= -64 && rel <= 64) ? vD1 : NEGBIG; }
#pragma unroll
                for (int k = 0; k < 5; ++k) { const int i = tid + 512 * k; const int rel = i - 1024; if (i < 2049) tabD4[i] = (rel >= -256 && rel <= 256) ? v4[k] : NEGBIG; }
#pragma unroll
                for (int k = 0; k < 7; ++k) { const int i = tid + 512 * k; const int rel = i - TABD_C; if (i < TABD_N) tabD16[i] = (rel >= -1024 && rel <= 1024) ? v16[k] : NEGBIG; }
                tabNEG[tid] = NEGBIG;
#pragma unroll
                for (int k = 0; k < 4; ++k) { const int i = tid + 512 * k; if (i < 15 * 128) tabB[i] = vB[k]; }
#pragma unroll
                for (int k = 0; k < 12; ++k) { const int p = tid + 512 * k; const int pc = p % 6, c = (p / 6) & 15, d = p / 96;
                    LAS unsigned short* row = (LAS unsigned short*)(VIM + d * VSL_PITCH);
#pragma unroll
                    for (int j = 0; j < 8; ++j) { const int tl = 128 * pc - 64 + 16 * j + c; const unsigned e = (j & 1) ? (wv[k][j >> 1] >> 16) : (wv[k][j >> 1] & 0xffffu); if (tl >= 0 && tl < 640) row[tl] = (unsigned short)e; } }
            }
            __syncthreads();
            const int r32 = lane & 31, hi = lane >> 5, lam = lam_of(r32);
            const LAS char* negp = (const LAS char*)tabNEG;
            const char* PB = (const char*)PROJ;
            {
                const int tl0 = 64 * wave, q0 = 512 * v32 + tl0, tqa = q0 + r32, tqb = tqa + 32;
                bf16x8 qa[4], qb[4]; const bf16_t* qp = PROJ + (size_t)tqa * PP + C_QD + h * 64 + 8 * hi;
#pragma unroll
                for (int d0 = 0; d0 < 4; ++d0) { qa[d0] = *(const bf16x8*)(qp + 16 * d0); qb[d0] = *(const bf16x8*)(qp + (size_t)32 * PP + 16 * d0); }
                LA sa, sb; sa.o0 = zero16(); sa.o1 = sa.o0; sa.m = NEGBIG; sa.l = 0.f; sb.o0 = zero16(); sb.o1 = sb.o0; sb.m = NEGBIG; sb.l = 0.f;
                const unsigned kc = (unsigned)(C_KD + h * 64 + 8 * hi);
                const VSL vs{(const LAS char*)VIM};
                auto tile = [&](int i) -> TP { const int t0r = q0 - 64 + 32 * i; const bool ok = t0r >= 0 && t0r < SEQ; const int t0 = ok ? t0r : q0; TP t;
                    t.koff = ((unsigned)(t0 + lam) * PP + kc) * 2u; t.voff = (unsigned)(r32 * VSL_PITCH + (tl0 + 32 * i + 8 * hi) * 2);
                    t.tp = (ok && i <= 4) ? (const LAS char*)(tabD1 + (TABA_C + t0 + 8 * hi - tqa)) : negp;
                    t.tp2 = (ok && i >= 1) ? (const LAS char*)(tabD1 + (TABA_C + t0 + 8 * hi - tqb)) : negp; t.cb = 0; return t; };
                LA_RUN2(6, tile, MB_A, 32, PB, vs);
                __syncthreads();
#pragma unroll
                for (int w2 = 0; w2 < 2; ++w2) { const LA& st = w2 ? sb : sa;
                    float lt = st.l; { auto rr = __builtin_amdgcn_permlane32_swap(__float_as_uint(lt), __float_as_uint(lt), false, false); lt = __uint_as_float(rr[0]) + __uint_as_float(rr[1]); }
                    const float inv = 1.f / lt; const int rho = tl0 + 32 * w2 + r32;
                    if (hi == 0) LSE1[rho] = st.m + __builtin_amdgcn_logf(lt);
#pragma unroll
                    for (int db = 0; db < 2; ++db)
#pragma unroll
                        for (int g = 0; g < 4; ++g) { const f32x16& o = db ? st.o1 : st.o0; u32x2 w; w.x = cvt_pk_bf16(o[4 * g] * inv, o[4 * g + 1] * inv); w.y = cvt_pk_bf16(o[4 * g + 2] * inv, o[4 * g + 3] * inv);
                            *(LAS u32x2*)(O1 + o1_off(rho, 8 * db + 2 * g + hi)) = w; } }
            }
            {
                const int q0 = 64 * (v32 * 8 + wave), tqa = q0 + r32, tqb = tqa + 32, kvh = h >> 2;
                bf16x8 qa[4], qb[4]; const bf16_t* qp = PROJ + (size_t)tqa * PP + C_QA + h * 64 + 8 * hi;
#pragma unroll
                for (int d0 = 0; d0 < 4; ++d0) { qa[d0] = *(const bf16x8*)(qp + 16 * d0); qb[d0] = *(const bf16x8*)(qp + (size_t)32 * PP + 16 * d0); }
                LA sa, sb; sa.o0 = zero16(); sa.o1 = sa.o0; sa.m = NEGBIG; sa.l = 0.f; sb.o0 = zero16(); sb.o1 = sb.o0; sb.m = NEGBIG; sb.l = 0.f;
                u32x2 za[8], zb[8]; la_loadz(za, PROJ + (size_t)tqa * PP + C_ZA + h * 64, hi); la_loadz(zb, PROJ + (size_t)tqb * PP + C_ZA + h * 64, hi);
                const int vd = kvh * 64 + r32; const unsigned kc = (unsigned)(C_KA + kvh * 64 + 8 * hi);
                const VSG vs{(const char*)VTA};
                auto tile = [&](int i) -> TP { const int t0r = q0 - 128 + 32 * i; const bool ok = t0r >= 0 && t0r < SEQ; const int t0 = ok ? t0r : q0; TP t;
                    t.koff = ((unsigned)(t0 + lam) * PP + kc) * 2u; t.voff = (unsigned)(vt_off(vd, t0 + 8 * hi) * 2);
                    t.tp = (ok && i <= 8) ? (const LAS char*)(tabA + (TABA_C + t0 + 8 * hi - tqa)) : negp;
                    t.tp2 = (ok && i >= 1) ? (const LAS char*)(tabA + (TABA_C + t0 + 8 * hi - tqb)) : negp; t.cb = 0; return t; };
                LA_RUN2(10, tile, MB_A, 32, PB, vs);
                const float sk2 = attn_sink[l * 8 + h] * LOG2E;
                la_store(sa, true, sk2, za, Yb + (size_t)tqa * DMODEL + h * 64, hi);
                la_store(sb, true, sk2, zb, Yb + (size_t)tqb * DMODEL + h * 64, hi);
            }
            {
                const int qh = wave & 1, qrow = 8 * v32 + 2 * (wave >> 1), qc = 32 * qh + r32, tqa = 64 * qrow + qc, tqb = tqa + 64;
                int rsa = qrow - 4; rsa = rsa < 0 ? 0 : (rsa > 248 ? 248 : rsa); int rsb = qrow - 3; rsb = rsb < 0 ? 0 : (rsb > 248 ? 248 : rsb); int cs = qc - 8; cs = cs < 0 ? 0 : (cs > 48 ? 48 : cs);
                bf16x8 qa[4], qb[4]; const bf16_t* qp = PROJ + (size_t)tqa * PP + C_QB + h * 64 + 8 * hi;
#pragma unroll
                for (int d0 = 0; d0 < 4; ++d0) { qa[d0] = *(const bf16x8*)(qp + 16 * d0); qb[d0] = *(const bf16x8*)(qp + (size_t)64 * PP + 16 * d0); }
                LA sa, sb; sa.o0 = zero16(); sa.o1 = sa.o0; sa.m = NEGBIG; sa.l = 0.f; sb.o0 = zero16(); sb.o1 = sb.o0; sb.m = NEGBIG; sb.l = 0.f;
                const int vd = h * 64 + r32; const unsigned kc = (unsigned)(C_KB + h * 64 + 8 * hi);
                const VSG vs{(const char*)VTB};
                const LAS char* bb0 = (const LAS char*)(tabB + ((7 - qrow) * 128 + 32 * qh + 8 * hi - qc + 64));
                const int cbr = 32 * qh + 8 * hi - cs;
                auto tile = [&](int i) -> TP { const int kr = rsa + i, krc = kr > 255 ? 255 : kr, t0 = 64 * krc + 32 * qh; const bool va = i <= 7, vb = kr >= rsb && kr < rsb + 8; TP t;
                    t.koff = ((unsigned)(t0 + lam) * PP + kc) * 2u; t.voff = (unsigned)(vt_off(vd, t0 + 8 * hi) * 2);
                    const LAS char* bp = bb0 + kr * 512;
                    t.tp = va ? bp : negp; t.tp2 = vb ? bp - 512 : negp; t.cb = cbr; return t; };
                LA_RUN2(9, tile, MB_B, 32, PB, vs);
                const int c0 = qh ? 24 : 32;
                {   LA& st = sa; const bf16x8 (&qf)[4] = qa;
                    auto tilx = [&](int i) -> TP { const int kr0 = rsa + 4 * i, t0 = 64 * kr0 + c0, tk = t0 + (lam & 7) + (lam >> 3) * 64; TP t;
                        t.koff = ((unsigned)tk * PP + kc) * 2u; t.voff = (unsigned)(vt_off(vd, t0 + hi * 64) * 2);
                        t.tp = (const LAS char*)(tabB + ((kr0 + hi - qrow + 7) * 128 + c0 - qc + 64)); t.cb = c0 - cs; t.tp2 = t.tp; return t; };
                    LA_RUN(2, tilx, MB_BX, 512, PB, vs); }
                {   LA& st = sb; const bf16x8 (&qf)[4] = qb;
                    auto tilx = [&](int i) -> TP { const int kr0 = rsb + 4 * i, t0 = 64 * kr0 + c0, tk = t0 + (lam & 7) + (lam >> 3) * 64; TP t;
                        t.koff = ((unsigned)tk * PP + kc) * 2u; t.voff = (unsigned)(vt_off(vd, t0 + hi * 64) * 2);
                        t.tp = (const LAS char*)(tabB + ((kr0 + hi - qrow - 1 + 7) * 128 + c0 - qc + 64)); t.cb = c0 - cs; t.tp2 = t.tp; return t; };
                    LA_RUN(2, tilx, MB_BX, 512, PB, vs); }
                u32x2 zv[8];
                la_loadz(zv, PROJ + (size_t)tqa * PP + C_ZB + h * 64, hi); la_store(sa, false, 0.f, zv, Yb + (size_t)tqa * DMODEL + 512 + h * 64, hi);
                la_loadz(zv, PROJ + (size_t)tqb * PP + C_ZB + h * 64, hi); la_store(sb, false, 0.f, zv, Yb + (size_t)tqb * DMODEL + 512 + h * 64, hi);
            }
            __syncthreads();
            {
                const int cA = (wave & 3) + 8 * (wave >> 2), cB = cA + 4, s0 = 32 * v32, tqa = 16 * (s0 + r32) + cA, tqb = tqa + 4;
                bf16x8 qa[4], qb[4]; const bf16_t* qp = PROJ + (size_t)tqa * PP + C_QD + h * 64 + 8 * hi;
#pragma unroll
                for (int d0 = 0; d0 < 4; ++d0) { qa[d0] = *(const bf16x8*)(qp + 16 * d0); qb[d0] = *(const bf16x8*)(qp + (size_t)4 * PP + 16 * d0); }
                LA sa, sb;
#pragma unroll
                for (int w2 = 0; w2 < 2; ++w2) { LA& st = w2 ? sb : sa; const int rho = 16 * r32 + (w2 ? cB : cA);
                    st.m = LSE1[rho]; st.l = hi ? 0.f : 1.f;
#pragma unroll
                    for (int db = 0; db < 2; ++db)
#pragma unroll
                        for (int g = 0; g < 4; ++g) { const u32x2 w = *(const LAS u32x2*)(O1 + o1_off(rho, 8 * db + 2 * g + hi));
                            if (db) { st.o1[4 * g] = bf_lo(w.x); st.o1[4 * g + 1] = bf_hi(w.x); st.o1[4 * g + 2] = bf_lo(w.y); st.o1[4 * g + 3] = bf_hi(w.y); }
                            else { st.o0[4 * g] = bf_lo(w.x); st.o0[4 * g + 1] = bf_hi(w.x); st.o0[4 * g + 2] = bf_lo(w.y); st.o0[4 * g + 3] = bf_hi(w.y); } } }
                const int vd = h * 64 + r32; const unsigned kc = (unsigned)(C_KD + h * 64 + 8 * hi);
                const VSG vs{(const char*)VTD};
                {
                    LA& st = sa; const bf16x8 (&qf)[4] = qa;
                    auto t16 = [&](int i) -> TP { const int sbr = s0 - 64 + 32 * i; const bool ok = sbr >= 0 && sbr < 1024; const int sb_ = ok ? sbr : s0;
                        const int t0 = 16 * sb_ + cA, tk = t0 + (lam & 7) * 16 + (lam >> 3) * 128; TP t;
                        t.koff = ((unsigned)tk * PP + kc) * 2u; t.voff = (unsigned)(vt_off(vd, cA * 1024 + sb_ + 8 * hi) * 2);
                        t.tp = ok ? (const LAS char*)(tabD16 + (TABD_C + t0 + hi * 128 - tqa)) : negp; t.cb = 0; t.tp2 = t.tp; return t; };
                    LA_RUN(5, t16, MB_D16, 32, PB, vs);
                }
                {
                    LA& st = sb; const bf16x8 (&qf)[4] = qb;
                    auto t16 = [&](int i) -> TP { const int sbr = s0 - 64 + 32 * i; const bool ok = sbr >= 0 && sbr < 1024; const int sb_ = ok ? sbr : s0;
                        const int t0 = 16 * sb_ + cB, tk = t0 + (lam & 7) * 16 + (lam >> 3) * 128; TP t;
                        t.koff = ((unsigned)tk * PP + kc) * 2u; t.voff = (unsigned)(vt_off(vd, cB * 1024 + sb_ + 8 * hi) * 2);
                        t.tp = ok ? (const LAS char*)(tabD16 + (TABD_C + t0 + hi * 128 - tqb)) : negp; t.cb = 0; t.tp2 = t.tp; return t; };
                    LA_RUN(5, t16, MB_D16, 32, PB, vs);
                }
                auto t4 = [&](int i) -> TP { const int cq = (cA & 3) + 4 * (i >> 1), sb_ = s0 - 16 + 32 * (i & 1);
                    const int t0 = 16 * sb_ + cq; int tk = t0 + (lam & 7) * 16 + (lam >> 3) * 128; tk = tk < 0 ? 0 : (tk > SEQ - 1 ? SEQ - 1 : tk); TP t;
                    t.koff = ((unsigned)tk * PP + kc) * 2u; t.voff = (unsigned)(vt_off(vd, cq * 1024 + sb_ + 8 * hi) * 2);
                    t.tp = (const LAS char*)(tabD4 + (1024 + t0 + hi * 128 - tqa)); t.tp2 = t.tp - 16; t.cb = (sb_ < 0 ? 1 : 0) | (sb_ + 32 > 1024 ? 2 : 0); return t; };
                LA_RUN2(8, t4, MB_D4M, 96, PB, vs);
                u32x2 zv[8];
                la_loadz(zv, PROJ + (size_t)tqa * PP + C_ZD + h * 64, hi); la_store(sa, false, 0.f, zv, Yb + (size_t)tqa * DMODEL + 1536 + h * 64, hi);
                la_loadz(zv, PROJ + (size_t)tqb * PP + C_ZD + h * 64, hi); la_store(sb, false, 0.f, zv, Yb + (size_t)tqb * DMODEL + 1536 + h * 64, hi);
            }
            __syncthreads();
        }
        SEAM(pb + 2);
        if (IN(pb + 3)) {
            PHASE_BEGIN
            const float* xcur = (l == 0) ? x_in : XR;
            pg8::SchedOut S{(const char*)Yb, (const char*)(WOUTT + (size_t)l * DMODEL * DMODEL), G, bx};
            pg8::EpiOut E{xcur, XR, MODV + l * 6144 + 4096};
            pg8::gemm_phase<pg8::EpiOut, pg8::SchedOut>(tid, lds, DMODEL, S, E);
        }
        SEAM(pb + 3);
    }
    if (IN(17)) {
        PHASE_BEGIN
        for (int m = gw; m < SEQ; m += NGW) {
            const f32x4* xr = (const f32x4*)(XR + (size_t)m * DMODEL) + lane;
            f32x4 v[8]; float s = 0.f;
#pragma unroll
            for (int j = 0; j < 8; ++j) { v[j] = xr[64 * j]; s += (v[j][0] * v[j][0] + v[j][1] * v[j][1]) + (v[j][2] * v[j][2] + v[j][3] * v[j][3]); }
            const float rstd = __builtin_amdgcn_rsqf(wave_sum(s) * (1.f / DMODEL) + EPS);
            f32x4* o = (f32x4*)(out_p + (size_t)m * DMODEL) + lane;
#pragma unroll
            for (int j = 0; j < 8; ++j) { const f32x4 g = *((const f32x4*)final_norm_w + lane + 64 * j); o[64 * j] = v[j] * rstd * g; }
        }
    }
#undef IN
#undef SEAM
}

extern "C" void kernel_launch(void* const* d_in, const int* in_sizes, int n_in, void* d_out, int out_size, void* d_ws, size_t ws_size, hipStream_t stream) {
    static int grid = 0;
    if (grid == 0) {
        if (n_in != 13 || ws_size < WS_END) { fprintf(stderr, "kernel_launch: unexpected inputs (n_in %d, ws %zu)\n", n_in, ws_size); grid = -1; return; }
        int dev = 0, cus = 0, per_cu = 0;
        (void)hipGetDevice(&dev); (void)hipDeviceGetAttribute(&cus, hipDeviceAttributeMultiprocessorCount, dev);
        (void)hipFuncSetAttribute((const void*)mk_fwd, hipFuncAttributeMaxDynamicSharedMemorySize, LDS_BYTES);
        (void)hipOccupancyMaxActiveBlocksPerMultiprocessor(&per_cu, (const void*)mk_fwd, NWAVES * 64, LDS_BYTES);
        (void)hipGetLastError();
        if (per_cu < 1) fprintf(stderr, "kernel_launch: occupancy query says %d blocks per CU\n", per_cu);
        grid = cus;
    }
    if (grid < 0) return;
    (void)hipMemsetAsync(d_ws, 0, 16384, stream);
    Args a{};
    for (int i = 0; i < 13; ++i) a.in[i] = (const float*)d_in[i];
    a.out = (float*)d_out; a.ws = (unsigned char*)d_ws;
#if MK_ONE_LAUNCH
    a.ph_lo = 0; a.ph_hi = 18;
    void* kargs[] = {&a};
    hipError_t e = hipLaunchCooperativeKernel((const void*)mk_fwd, dim3(grid), dim3(NWAVES * 64), kargs, LDS_BYTES, stream);
    if (e != hipSuccess) fprintf(stderr, "cooperative launch failed: %s (grid %d)\n", hipGetErrorString(e), grid);
#else
    for (int p = 0; p < 18; ++p) { a.ph_lo = p; a.ph_hi = p + 1; hipLaunchKernelGGL(mk_fwd, dim3(grid), dim3(NWAVES * 64), LDS_BYTES, stream, a); }
#endif
}
```

```cpp
#include <hip/hip_runtime.h>
#include <hip/hip_cooperative_groups.h>
#include <hip/hip_bf16.h>
#include <cstdio>
#include <cstdint>
#include <cmath>
namespace cg = cooperative_groups;

#ifndef MK_ONE_LAUNCH
#define MK_ONE_LAUNCH 1
#endif

#define LAS __attribute__((address_space(3)))
#define GAS __attribute__((address_space(1)))
typedef unsigned short bf16_t;
typedef short bf16x8 __attribute__((ext_vector_type(8)));
typedef float f32x4 __attribute__((ext_vector_type(4)));
typedef float f32x2 __attribute__((ext_vector_type(2)));
typedef float f32x16 __attribute__((ext_vector_type(16)));
typedef unsigned u32x4 __attribute__((ext_vector_type(4)));
typedef unsigned u32x2 __attribute__((ext_vector_type(2)));

constexpr int SEQ = 16384, DMODEL = 2048, NIN = 6656, DEPTH = 4;
constexpr int PP = NIN + 64;
constexpr int VTPP = 2 * SEQ + 64;
__host__ __device__ __forceinline__ int vt_off(int d, int p) { return (d >> 1) * VTPP + (p >> 5) * 64 + (d & 1) * 32 + (p & 31); }
constexpr int C_QA = 0, C_KA = 512, C_VA = 640, C_ZA = 768, C_QB = 1280, C_KB = 1792, C_VB = 2304, C_ZB = 2816;
constexpr int C_QC = 3328, C_KC = 3840, C_VC = 3968, C_ZC = 4096, C_QD = 4608, C_KD = 5120, C_VD = 5632, C_ZD = 6144;
constexpr float LOG2E = 1.4426950408889634f;
constexpr float C2 = 0.125f * LOG2E;
constexpr float EPS = 1e-6f;
constexpr float NEGBIG = -1e30f;

constexpr size_t MiB = 1u << 20;
constexpr size_t WS_MODV = 1 * MiB;
constexpr size_t WS_TABA = 1 * MiB + 128 * 1024;
constexpr size_t WS_TABD = 1 * MiB + 192 * 1024;
constexpr size_t WS_CS = 2 * MiB;
constexpr size_t WS_WINT = 8 * MiB;
constexpr size_t WS_WOUTT = 112 * MiB;
constexpr size_t WS_H = 144 * MiB;
constexpr size_t WS_PROJ = 208 * MiB;
constexpr size_t WS_VTA = 420 * MiB;
constexpr size_t WS_VTB = 426 * MiB;
constexpr size_t WS_VTD = 444 * MiB;
constexpr size_t WS_Y = 462 * MiB;
constexpr size_t WS_XR = 526 * MiB;
constexpr size_t WS_HO = 654 * MiB;
constexpr size_t WS_HL = 672 * MiB;
constexpr size_t WS_END = 674 * MiB;
static_assert(WS_PROJ + (size_t)SEQ * PP * 2 <= WS_VTA && WS_VTA + (size_t)64 * VTPP * 2 <= WS_VTB && WS_VTB + (size_t)256 * VTPP * 2 <= WS_VTD && WS_VTD + (size_t)256 * VTPP * 2 <= WS_Y, "d_ws map");
constexpr int TABA_N = 320, TABA_C = 160, TABD_N = 3073, TABD_C = 1536;

constexpr int NWAVES = 8;
constexpr int LDS_BYTES = 147456;

typedef float f32x2_c __attribute__((ext_vector_type(2))); typedef __bf16 bf16x2_c __attribute__((ext_vector_type(2)));
__device__ __forceinline__ unsigned cvt_pk_bf16(float lo, float hi) { f32x2_c v = {lo, hi}; bf16x2_c b = __builtin_convertvector(v, bf16x2_c); return __builtin_bit_cast(unsigned, b); }
__device__ __forceinline__ float bf_lo(unsigned u) { return __builtin_bit_cast(float, u << 16); }
__device__ __forceinline__ float bf_hi(unsigned u) { return __builtin_bit_cast(float, u & 0xffff0000u); }
__device__ __forceinline__ float silu_f(float z) { return z / (1.f + __expf(-z)); }
__device__ __forceinline__ float wave_sum(float v) {
#pragma unroll
    for (int o = 1; o < 64; o <<= 1) v += __shfl_xor(v, o);
    return v;
}

namespace pg8 {
constexpr int BM = 256, BK = 64, HALF = 128, HTB = HALF * BK * 2, STAGE_BYTES = 8 * HTB, NXCD = 8, WGM = 8;
__host__ __device__ __forceinline__ int lds_byte(int r, int c) { const int st = (r >> 4) * 2 + (c >> 5), rr = r & 15, cc = c & 31, ob = rr * 64 + cc * 2; return st * 1024 + (ob ^ (((ob >> 9) & 1) << 5)); }
__host__ __device__ __forceinline__ void stage_rc(int b, int& R, int& C) { const int st = b / 1024, sb = b % 1024, swz = sb ^ (((sb >> 9) & 1) << 5); R = (st >> 1) * 16 + swz / 64; C = (st & 1) * 32 + (swz % 64) / 2; }
__host__ __device__ __forceinline__ int perm32(int rho) { const int n = rho >> 4, i = rho & 15; return 8 * (i >> 2) + 4 * n + (i & 3); }

struct Unit { const char* a; const char* b; unsigned ldb2; int kind, pm, pn; };

template <class Epi, class Sched>
__device__ __forceinline__ void gemm_phase(const int tid, LAS unsigned char* lds, const int K, const Sched& S, const Epi& E) {
    const int wid = __builtin_amdgcn_readfirstlane(tid >> 6), lane = tid & 63, wr = wid >> 2, wc = wid & 3, fr = lane & 15, fq = lane >> 4;
    const int nt = K / BK;
    unsigned voffA[2], rB[2], cB2[2];
#pragma unroll
    for (int i = 0; i < 2; ++i) { int R, C; stage_rc(tid * 16 + i * 8192, R, C); const int Rb = (R & ~31) + perm32(R & 31);
        voffA[i] = (unsigned)(R * K + C) * 2u; rB[i] = (unsigned)Rb; cB2[i] = (unsigned)C * 2u; }
    const size_t kstep = (size_t)(BK * 2);
    const size_t hstepA = (size_t)HALF * K * 2;
    const unsigned ldsw = (unsigned)wid * 1024u;
    const int aoff = lds_byte(wr * 64 + fr, fq * 8), boff = lds_byte(wc * 32 + fr, fq * 8);
#define PG8_SA(b, h) (((b) * 2 + (h)) * HTB)
#define PG8_SB(b, h) ((4 + (b) * 2 + (h)) * HTB)
#define PG8_STAGE(bufoff, gbase, v0, v1) do { \
        __builtin_amdgcn_global_load_lds((const unsigned*)((const char*)(gbase) + (v0)), (LAS unsigned*)(lds + (bufoff) + ldsw), 16, 0, 0); \
        __builtin_amdgcn_global_load_lds((const unsigned*)((const char*)(gbase) + (v1)), (LAS unsigned*)(lds + (bufoff) + ldsw + 8192), 16, 0, 0); } while (0)
#define PG8_LDA(dst, b, h) do { _Pragma("unroll") for (int m = 0; m < 4; ++m) _Pragma("unroll") for (int k = 0; k < 2; ++k) dst[m][k] = *(const LAS bf16x8*)(lds + PG8_SA(b, h) + aoff + m * 2048 + k * 1024); } while (0)
#define PG8_LDB(dst, b, h) do { _Pragma("unroll") for (int n = 0; n < 2; ++n) _Pragma("unroll") for (int k = 0; k < 2; ++k) dst[n][k] = *(const LAS bf16x8*)(lds + PG8_SB(b, h) + boff + n * 2048 + k * 1024); } while (0)
#define PG8_MMA(ai, bj, At, Bt) do { __builtin_amdgcn_s_setprio(1); _Pragma("unroll") for (int m = 0; m < 4; ++m) _Pragma("unroll") for (int n = 0; n < 2; ++n) _Pragma("unroll") for (int k = 0; k < 2; ++k) \
        acc[ai][bj][m][n] = __builtin_amdgcn_mfma_f32_16x16x32_bf16(Bt[n][k], At[m][k], acc[ai][bj][m][n], 0, 0, 0); __builtin_amdgcn_s_setprio(0); } while (0)
#define PG8_WAIT_V(n) asm volatile("s_waitcnt vmcnt(" #n ")" ::: "memory")
#define PG8_WAIT_L(n) asm volatile("s_waitcnt lgkmcnt(" #n ")" ::: "memory")
#define PG8_BAR __builtin_amdgcn_s_barrier()
#define PG8_SCHED __builtin_amdgcn_sched_barrier(0)
    Unit cur, nxt; int ui = 0;
    if (!S.next(0, cur)) return;
    f32x4 acc[2][2][4][2];
#pragma unroll
    for (int a = 0; a < 2; ++a)
#pragma unroll
        for (int b = 0; b < 2; ++b)
#pragma unroll
            for (int m = 0; m < 4; ++m)
#pragma unroll
                for (int n = 0; n < 2; ++n) acc[a][b][m][n] = (f32x4){0.f, 0.f, 0.f, 0.f};
    bf16x8 At[4][2], B0[2][2], B1[2][2];
    const char* cA = cur.a; const char* cB = cur.b;
    unsigned vc0 = rB[0] * cur.ldb2 + cB2[0], vc1 = rB[1] * cur.ldb2 + cB2[1]; size_t hBc = (size_t)HALF * cur.ldb2;
    {
        PG8_STAGE(PG8_SB(0, 0), cB, vc0, vc1); PG8_STAGE(PG8_SB(0, 1), cB + hBc, vc0, vc1); PG8_STAGE(PG8_SA(0, 0), cA, voffA[0], voffA[1]); PG8_STAGE(PG8_SA(0, 1), cA + hstepA, voffA[0], voffA[1]);
        if (wr == 1) PG8_BAR;
        PG8_WAIT_V(2); PG8_BAR;
        PG8_STAGE(PG8_SB(1, 0), cB + kstep, vc0, vc1); PG8_STAGE(PG8_SA(1, 0), cA + kstep, voffA[0], voffA[1]); PG8_STAGE(PG8_SB(1, 1), cB + hBc + kstep, vc0, vc1);
        PG8_WAIT_V(6); PG8_BAR;
    }
    for (;;) {
        const bool has_next = S.next(ui + 1, nxt);
        const char* nA = has_next ? nxt.a : cA; const char* nB = has_next ? nxt.b : cB;
        const unsigned nldb = has_next ? nxt.ldb2 : cur.ldb2;
        const unsigned vn0 = rB[0] * nldb + cB2[0], vn1 = rB[1] * nldb + cB2[1]; const size_t hBn = (size_t)HALF * nldb;
        for (int t = 0; t < nt; t += 2) {
            const bool last = (t == nt - 2);
            const char* a1 = cA + (size_t)(t + 1) * kstep;
            const char* a2 = last ? nA : cA + (size_t)(t + 2) * kstep; const char* b2 = last ? nB : cB + (size_t)(t + 2) * kstep;
            const char* a3 = a2 + kstep; const char* b3 = b2 + kstep;
            const unsigned v20 = last ? vn0 : vc0, v21 = last ? vn1 : vc1; const size_t hB2 = last ? hBn : hBc;
            PG8_LDB(B0, 0, 0); PG8_LDB(B1, 0, 1); PG8_SCHED; PG8_LDA(At, 0, 0); PG8_STAGE(PG8_SA(1, 1), a1 + hstepA, voffA[0], voffA[1]);
            PG8_WAIT_V(8); PG8_WAIT_L(0); PG8_BAR; PG8_MMA(0, 0, At, B0); PG8_MMA(0, 1, At, B1); PG8_BAR; PG8_SCHED;
            PG8_LDA(At, 0, 1); PG8_STAGE(PG8_SB(0, 0), b2, v20, v21); PG8_STAGE(PG8_SB(0, 1), b2 + hB2, v20, v21); PG8_STAGE(PG8_SA(0, 0), a2, voffA[0], voffA[1]);
            PG8_WAIT_V(8); PG8_WAIT_L(0); PG8_BAR; PG8_MMA(1, 0, At, B0); PG8_MMA(1, 1, At, B1); PG8_BAR; PG8_SCHED;
            PG8_LDB(B0, 1, 0); PG8_LDB(B1, 1, 1); PG8_SCHED; PG8_LDA(At, 1, 0); PG8_STAGE(PG8_SA(0, 1), a2 + hstepA, voffA[0], voffA[1]);
            PG8_WAIT_V(8); PG8_WAIT_L(0); PG8_BAR; PG8_MMA(0, 0, At, B0); PG8_MMA(0, 1, At, B1); PG8_BAR; PG8_SCHED;
            PG8_LDA(At, 1, 1); PG8_STAGE(PG8_SB(1, 0), b3, v20, v21); PG8_STAGE(PG8_SB(1, 1), b3 + hB2, v20, v21); PG8_STAGE(PG8_SA(1, 0), a3, voffA[0], voffA[1]);
            PG8_WAIT_V(8); PG8_WAIT_L(0); PG8_BAR; PG8_MMA(1, 0, At, B0); PG8_MMA(1, 1, At, B1); PG8_BAR; PG8_SCHED;
        }
        if (wr == 0) PG8_BAR;
        E(acc, cur, wr, wc, fr, fq);
        if (!has_next) break;
#pragma unroll
        for (int a = 0; a < 2; ++a)
#pragma unroll
            for (int b = 0; b < 2; ++b)
#pragma unroll
                for (int m = 0; m < 4; ++m)
#pragma unroll
                    for (int n = 0; n < 2; ++n) acc[a][b][m][n] = (f32x4){0.f, 0.f, 0.f, 0.f};
        cur = nxt; cA = nA; cB = nB; vc0 = vn0; vc1 = vn1; hBc = hBn; ++ui;
        if (wr == 1) PG8_BAR;
    }
    PG8_WAIT_V(0);
    PG8_BAR;
#undef PG8_SA
#undef PG8_SB
#undef PG8_STAGE
#undef PG8_LDA
#undef PG8_LDB
#undef PG8_MMA
#undef PG8_WAIT_V
#undef PG8_WAIT_L
#undef PG8_BAR
#undef PG8_SCHED
}

__device__ __forceinline__ void grouped(int wgid, int nM, int nN, int& pm, int& pn) {
    const int nwg = nM * nN; { const int q = nwg / NXCD, r = nwg % NXCD, xcd = wgid % NXCD, off = wgid / NXCD; wgid = (xcd < r ? xcd * (q + 1) : r * (q + 1) + (xcd - r) * q) + off; }
    const int nig = WGM * nN, gid = wgid / nig, fm = gid * WGM, gsz = (nM - fm) < WGM ? (nM - fm) : WGM;
    pm = fm + ((wgid % nig) % gsz); pn = (wgid % nig) / gsz;
}

struct SchedIn {
    const char* H; const char* W; int G, c;
    __device__ __forceinline__ bool next(int i, Unit& u) const {
        const int Lx = i * G + c; if (Lx >= 1728) return false;
        if (Lx < 1408) { int pm, pi; grouped(Lx, 64, 22, pm, pi); const int pn = pi + (pi >= 9 ? 2 : 0) + (pi >= 20 ? 2 : 0);
            u.a = H + (size_t)pm * 256 * DMODEL * 2; u.b = W + (size_t)pn * 256 * DMODEL * 2; u.ldb2 = DMODEL * 2; u.kind = 0; u.pm = pm; u.pn = pn; }
        else { const int l2 = Lx - 1408, ft = l2 >> 6, tt = l2 & 63; const int pmf = ft == 0 ? 2 : (ft == 1 ? 9 : (ft == 2 ? 10 : (ft == 3 ? 22 : 23)));
            u.a = W + (size_t)pmf * 256 * DMODEL * 2;
            if (ft < 3) { u.b = H + (size_t)tt * 256 * DMODEL * 2; u.ldb2 = DMODEL * 2; }
            else { u.b = H + (size_t)(16 * 256 * (tt & 3) + (tt >> 2)) * DMODEL * 2; u.ldb2 = 16 * DMODEL * 2; }
            u.kind = 1; u.pm = ft; u.pn = tt; }
        return true;
    }
};
struct SchedOut {
    const char* Y; const char* W; int G, c;
    __device__ __forceinline__ bool next(int i, Unit& u) const {
        const int Lx = i * G + c; if (Lx >= 512) return false;
        int pm, pn; grouped(Lx, 64, 8, pm, pn);
        u.a = Y + (size_t)pm * 256 * DMODEL * 2; u.b = W + (size_t)pn * 256 * DMODEL * 2; u.ldb2 = DMODEL * 2; u.kind = 0; u.pm = pm; u.pn = pn; return true;
    }
};

struct EpiIn {
    bf16_t* PROJ; bf16_t* VTA; bf16_t* VTB; bf16_t* VTD; const float* CS; const float* qnw; const float* knw;
    __device__ __forceinline__ void operator()(const f32x4 (&acc)[2][2][4][2], const Unit& u, int wr, int wc, int fr, int fq) const {
        asm volatile("" : "+v"(fr), "+v"(fq));
        if (u.kind == 1) {
            const int ft = u.pm, tt = u.pn; bf16_t* base; int fbase, ai_lo = 0;
            if (ft == 0) { base = VTA; fbase = -128; ai_lo = 1; } else if (ft < 3) { base = VTB; fbase = (ft - 1) * 256; } else { base = VTD; fbase = (ft - 3) * 256; }
            for (int ai = ai_lo; ai < 2; ++ai)
#pragma unroll
                for (int m = 0; m < 4; ++m) { bf16_t* rowp = base + vt_off(fbase + 128 * ai + 64 * wr + 16 * m + fr, 256 * tt + 32 * wc + 8 * fq);
#pragma unroll
                    for (int bj = 0; bj < 2; ++bj) { const f32x4 v0 = ai ? acc[1][bj][m][0] : acc[0][bj][m][0], v1 = ai ? acc[1][bj][m][1] : acc[0][bj][m][1];
                        u32x4 w; w.x = cvt_pk_bf16(v0[0], v0[1]); w.y = cvt_pk_bf16(v0[2], v0[3]); w.z = cvt_pk_bf16(v1[0], v1[1]); w.w = cvt_pk_bf16(v1[2], v1[3]);
                        *(u32x4*)(rowp + bj * 256) = w; } }
            return;
        }
        const int pn = u.pn; const int row0 = u.pm * BM + wr * 64 + fr;
        if (pn >= 13 && pn <= 15) {
            const bool nrm = (pn < 15) || (wc < 2); const float* nw = (pn < 15) ? qnw : knw; const float sc = (pn < 15) ? C2 : 1.f;
            f32x4 wv[2][2];
#pragma unroll
            for (int bj = 0; bj < 2; ++bj)
#pragma unroll
                for (int n = 0; n < 2; ++n) wv[bj][n] = *(const f32x4*)(nw + 32 * bj + 8 * fq + 4 * n);
#pragma unroll
            for (int ai = 0; ai < 2; ++ai)
#pragma unroll
                for (int m = 0; m < 4; ++m) { const int row = row0 + ai * HALF + m * 16; bf16_t* rowp = PROJ + (size_t)row * PP + pn * 256 + 64 * wc + 8 * fq;
                    f32x4 v[2][2];
#pragma unroll
                    for (int bj = 0; bj < 2; ++bj)
#pragma unroll
                        for (int n = 0; n < 2; ++n) v[bj][n] = acc[ai][bj][m][n];
                    if (nrm) {
                        float ss = 0.f;
#pragma unroll
                        for (int bj = 0; bj < 2; ++bj)
#pragma unroll
                            for (int n = 0; n < 2; ++n) ss += v[bj][n][0] * v[bj][n][0] + v[bj][n][1] * v[bj][n][1] + v[bj][n][2] * v[bj][n][2] + v[bj][n][3] * v[bj][n][3];
                        ss += __shfl_xor(ss, 16); ss += __shfl_xor(ss, 32);
                        const float rinv = __builtin_amdgcn_rsqf(ss * (1.f / 64.f) + EPS);
#pragma unroll
                        for (int bj = 0; bj < 2; ++bj)
#pragma unroll
                            for (int n = 0; n < 2; ++n) { const f32x4 x = v[bj][n] * wv[bj][n] * rinv; const f32x4 cs = *(const f32x4*)(CS + ((size_t)row * 32 + 16 * bj + 4 * fq + 2 * n) * 2);
                                f32x4 o; o[0] = x[0] * cs[0] - x[1] * cs[1]; o[1] = x[0] * cs[1] + x[1] * cs[0]; o[2] = x[2] * cs[2] - x[3] * cs[3]; o[3] = x[2] * cs[3] + x[3] * cs[2]; v[bj][n] = o * sc; }
                    }
#pragma unroll
                    for (int bj = 0; bj < 2; ++bj) { u32x4 w; w.x = cvt_pk_bf16(v[bj][0][0], v[bj][0][1]); w.y = cvt_pk_bf16(v[bj][0][2], v[bj][0][3]); w.z = cvt_pk_bf16(v[bj][1][0], v[bj][1][1]); w.w = cvt_pk_bf16(v[bj][1][2], v[bj][1][3]);
                        *(u32x4*)(rowp + 32 * bj) = w; } }
            return;
        }
        const float sc = (pn == 0 || pn == 1 || pn == 5 || pn == 6 || pn == 18 || pn == 19) ? C2 : 1.f;
        const int col0 = pn * BM + wc * 32 + 8 * fq;
#pragma unroll
        for (int ai = 0; ai < 2; ++ai)
#pragma unroll
            for (int m = 0; m < 4; ++m) { bf16_t* rowp = PROJ + (size_t)(row0 + ai * HALF + m * 16) * PP + col0;
#pragma unroll
                for (int bj = 0; bj < 2; ++bj) { const f32x4 v0 = acc[ai][bj][m][0] * sc, v1 = acc[ai][bj][m][1] * sc;
                    u32x4 w; w.x = cvt_pk_bf16(v0[0], v0[1]); w.y = cvt_pk_bf16(v0[2], v0[3]); w.z = cvt_pk_bf16(v1[0], v1[1]); w.w = cvt_pk_bf16(v1[2], v1[3]);
                    *(u32x4*)(rowp + bj * HALF) = w; } }
    }
};

struct EpiOut {
    const float* xin; float* xout; const float* gate;
    __device__ __forceinline__ void operator()(const f32x4 (&acc)[2][2][4][2], const Unit& u, int wr, int wc, int fr, int fq) const {
        asm volatile("" : "+v"(fr), "+v"(fq));
        const int row0 = u.pm * BM + wr * 64 + fr, col0 = u.pn * BM + wc * 32 + 8 * fq;
        f32x4 g[2][2];
#pragma unroll
        for (int bj = 0; bj < 2; ++bj)
#pragma unroll
            for (int n = 0; n < 2; ++n) g[bj][n] = *(const f32x4*)(gate + col0 + bj * HALF + 4 * n);
#pragma unroll
        for (int ai = 0; ai < 2; ++ai)
#pragma unroll
            for (int m = 0; m < 4; ++m) { const size_t ro = (size_t)(row0 + ai * HALF + m * 16) * DMODEL + col0;
#pragma unroll
                for (int bj = 0; bj < 2; ++bj)
#pragma unroll
                    for (int n = 0; n < 2; ++n) { const f32x4 x = *(const f32x4*)(xin + ro + bj * HALF + 4 * n); *(f32x4*)(xout + ro + bj * HALF + 4 * n) = x + g[bj][n] * acc[ai][bj][m][n]; } }
    }
};
}

namespace attn_body {
using bf16 = __hip_bfloat16;
using s16x4 = __attribute__((ext_vector_type(4))) short;
constexpr int D = 64, NW = 8, QBLK = 32, QB = QBLK * NW, KVBLK = 64;
__device__ __forceinline__ int crow(int r, int hi) { return (r & 3) + 8 * (r >> 2) + 4 * hi; }
#define SBAR() __builtin_amdgcn_sched_barrier(0)
constexpr int NSLOT = 3, SLOTB = 8192;
constexpr int LDS_K = 0, LDS_V = NSLOT * SLOTB, LDS_WS = 2 * NSLOT * SLOTB, LDS_OST = LDS_WS + NW * 64 * 4, LDS_BYTES = LDS_OST + NW * 4096;
__device__ __forceinline__ void glds16(const void* gsrc, unsigned lds_dst) { unsigned keep;
  asm volatile("s_mov_b32 %0, m0\n\ts_mov_b32 m0, %2\n\ts_nop 0\n\tglobal_load_lds_dwordx4 %1, off\n\ts_mov_b32 m0, %0" : "=&s"(keep) : "v"(gsrc), "s"(lds_dst) : "memory"); }
__device__ __forceinline__ float max3f(float a, float b, float c) { float r; asm("v_max3_f32 %0, %1, %2, %3" : "=v"(r) : "v"(a), "v"(b), "v"(c)); return r; }
__device__ __forceinline__ float max2f(float a, float b) { float r; asm("v_max_f32_e32 %0, %1, %2" : "=v"(r) : "v"(a), "v"(b)); return r; }
__device__ __forceinline__ float fadd_s(float a, float b) { float r; asm("v_add_f32_e32 %0, %1, %2" : "=v"(r) : "v"(a), "v"(b)); return r; }
__device__ __forceinline__ float fsub_s(float a, float b) { float r; asm("v_sub_f32_e32 %0, %1, %2" : "=v"(r) : "v"(a), "v"(b)); return r; }
typedef float f32x2_t __attribute__((ext_vector_type(2))); typedef __bf16 bf16x2_t __attribute__((ext_vector_type(2)));
__device__ __forceinline__ unsigned cvtpk_s(float lo, float hi) { f32x2_t v = {lo, hi}; bf16x2_t b = __builtin_convertvector(v, bf16x2_t); return __builtin_bit_cast(unsigned, b); }
#define WAIT_BAR(N) asm volatile("s_waitcnt vmcnt(" #N ") lgkmcnt(0)\n\ts_barrier" ::: "memory")
__device__ __forceinline__ void qkt(f32x16& p0, f32x16& p1, const char* Kslot, const bf16x8* qr, const f32x16& negm, int r32, int hi) {
  const char* kb = Kslot + hi * 1024 + r32 * 16;
  #pragma unroll
  for (int d0 = 0; d0 < 4; ++d0) {
    const bf16x8 b0 = *reinterpret_cast<const bf16x8*>(kb + d0 * 2048);
    const bf16x8 b1 = *reinterpret_cast<const bf16x8*>(kb + d0 * 2048 + 512);
    if (d0 == 0) { p0 = __builtin_amdgcn_mfma_f32_32x32x16_bf16(b0, qr[0], negm, 0, 0, 0); p1 = __builtin_amdgcn_mfma_f32_32x32x16_bf16(b1, qr[0], negm, 0, 0, 0); }
    else { p0 = __builtin_amdgcn_mfma_f32_32x32x16_bf16(b0, qr[d0], p0, 0, 0, 0); p1 = __builtin_amdgcn_mfma_f32_32x32x16_bf16(b1, qr[d0], p1, 0, 0, 0); } }
}
typedef __attribute__((address_space(3))) const char* lds_cptr;
typedef short v4i16_t __attribute__((ext_vector_type(4)));
__device__ __forceinline__ void kload8(bf16x8* kf, lds_cptr kp) {
  kf[0] = *(const LAS bf16x8*)(kp);        kf[1] = *(const LAS bf16x8*)(kp + 512);
  kf[2] = *(const LAS bf16x8*)(kp + 2048); kf[3] = *(const LAS bf16x8*)(kp + 2560);
  kf[4] = *(const LAS bf16x8*)(kp + 4096); kf[5] = *(const LAS bf16x8*)(kp + 4608);
  kf[6] = *(const LAS bf16x8*)(kp + 6144); kf[7] = *(const LAS bf16x8*)(kp + 6656);
}
__device__ __forceinline__ void kload2(bf16x8* kf, lds_cptr kp, int j) { kf[2 * j] = *(const LAS bf16x8*)(kp + j * 2048); kf[2 * j + 1] = *(const LAS bf16x8*)(kp + j * 2048 + 512); }
__device__ __forceinline__ s16x4 vtr(lds_cptr p) { return __builtin_bit_cast(s16x4, __builtin_amdgcn_ds_read_tr16_b64_v4i16((LAS v4i16_t*)p)); }
__device__ __forceinline__ float rowmax(const f32x16& p0, const f32x16& p1) {
  float a = max3f(p0[0], p0[1], p1[0]), b = max3f(p0[2], p0[3], p1[1]); a = max3f(a, p1[2], p1[3]);
  #pragma unroll
  for (int r = 4; r < 16; r += 4) { a = max3f(a, p0[r], p0[r + 1]); b = max3f(b, p0[r + 2], p0[r + 3]); a = max3f(a, p1[r], p1[r + 1]); b = max3f(b, p1[r + 2], p1[r + 3]); }
  const float m = max2f(a, b);
  auto rr = __builtin_amdgcn_permlane32_swap(__float_as_uint(m), __float_as_uint(m), false, false);
  return max2f(__uint_as_float(rr[0]), __uint_as_float(rr[1]));
}
__device__ __forceinline__ void pv(f32x16* o, int vb, bf16x8 pa0, bf16x8 pa1, bf16x8 pa2, bf16x8 pa3) {
  #pragma unroll
  for (int d0 = 0; d0 < 2; ++d0) { s16x4 lo[4], hi[4];
    #pragma unroll
    for (int ks = 0; ks < 4; ++ks) {
      asm volatile("ds_read_b64_tr_b16 %0,%1 offset:%c2" : "=&v"(lo[ks]) : "v"(vb), "i"(d0 * 4096 + ks * 1024) : "memory");
      asm volatile("ds_read_b64_tr_b16 %0,%1 offset:%c2" : "=&v"(hi[ks]) : "v"(vb), "i"(d0 * 4096 + ks * 1024 + 512) : "memory"); }
    asm volatile("s_waitcnt lgkmcnt(0)" ::: "memory"); SBAR();
    #define PK(k) (bf16x8){lo[k][0], lo[k][1], lo[k][2], lo[k][3], hi[k][0], hi[k][1], hi[k][2], hi[k][3]}
    o[d0] = __builtin_amdgcn_mfma_f32_32x32x16_bf16(pa0, PK(0), o[d0], 0, 0, 0);
    o[d0] = __builtin_amdgcn_mfma_f32_32x32x16_bf16(pa1, PK(1), o[d0], 0, 0, 0);
    o[d0] = __builtin_amdgcn_mfma_f32_32x32x16_bf16(pa2, PK(2), o[d0], 0, 0, 0);
    o[d0] = __builtin_amdgcn_mfma_f32_32x32x16_bf16(pa3, PK(3), o[d0], 0, 0, 0);
    #undef PK
  }
}

template <int THRL> __device__ __forceinline__ void attn_unit(const int tid, const float mfix, int q0, int NT, const bf16* Qh, const bf16* __restrict__ Kh, const bf16* __restrict__ Vh, const bf16* Zh, bf16* Oh, const long PQ, const long PO, char* shm) {
  const int lane = tid & 63, r32 = lane & 31, hi = lane >> 5; const int wid = __builtin_amdgcn_readfirstlane(tid >> 6);
  const bf16* Qw = Qh + (long)(q0 + wid * QBLK) * PQ;
  const unsigned lds0 = (unsigned)(uintptr_t)shm;
  float* wsf = (float*)(shm + LDS_WS) + wid * 64;
  const bf16* ksrc = Kh + (long)lane * PQ + wid * 8;
  const bf16* vsrc = Vh + (long)(16 * (wid & 3) + (lane >> 2)) * PQ + (wid >> 2) * 32 + (lane & 3) * 8;
  const unsigned kdst = lds0 + LDS_K + wid * 1024, vdst = lds0 + LDS_V + wid * 1024;
  #define DMA_K(t, slot) glds16(ksrc + (long)(t) * KVBLK * PQ, (unsigned)__builtin_amdgcn_readfirstlane(kdst + (slot)))
  #define DMA_V(t, slot) glds16(vsrc + (long)(t) * KVBLK * PQ, (unsigned)__builtin_amdgcn_readfirstlane(vdst + (slot)))
  const int vb0 = (int)(lds0 + LDS_V) + ((lane >> 4) & 1) * 32 + (lane & 3) * 8 + (4 * hi + ((lane & 15) >> 2)) * 64;
  const char* Kbase = shm + LDS_K; bf16x8 kf[8];
  const lds_cptr shm3 = (lds_cptr)shm; const lds_cptr kp0 = shm3 + LDS_K + hi * 1024 + r32 * 16; const lds_cptr vp0 = shm3 + LDS_V + ((lane >> 4) & 1) * 32 + (lane & 3) * 8 + (4 * hi + ((lane & 15) >> 2)) * 64;
  DMA_K(0, 0); DMA_V(0, 0); DMA_K(1, SLOTB);
  bf16x8 qr[4];
  #pragma unroll
  for (int d0 = 0; d0 < 4; ++d0) qr[d0] = *reinterpret_cast<const bf16x8*>(&Qw[(long)r32 * PQ + d0 * 16 + hi * 8]);
  float zf_; asm volatile("v_mov_b32 %0, 0" : "=v"(zf_)); f32x16 zv_;
  #pragma unroll
  for (int r = 0; r < 16; ++r) zv_[r] = zf_;
  float l_reg = 0.f; f32x16 o[2]; o[0] = zv_; o[1] = zv_; f32x16 negm;
  #pragma unroll
  for (int r = 0; r < 16; ++r) negm[r] = -mfix;
  asm volatile("" : "+v"(negm));
  #define START(P0, P1) do { _Pragma("unroll") for (int r = 0; r < 16; ++r) P0[r] = __builtin_amdgcn_exp2f(P0[r]); } while (0)
  #define RESC() do { } while (0)
  f32x16 pA0, pA1, pB0, pB1;
  int sl_prev = 0, sl_cur = 0, sl_next = SLOTB;
  #define ROT() do { sl_prev = sl_cur; sl_cur = sl_next; sl_next = (sl_next == (NSLOT - 1) * SLOTB) ? 0 : sl_next + SLOTB; } while (0)
  DMA_K(2, 2 * SLOTB);
  WAIT_BAR(3);
  qkt(pA0, pA1, Kbase, qr, negm, r32, hi); asm volatile("s_nop 15\n\ts_nop 7" : "+v"(pA0), "+v"(pA1));
  START(pA0, pA1);
  _Pragma("unroll") for (int r = 0; r < 16; ++r) pA1[r] = __builtin_amdgcn_exp2f(pA1[r]);
  WAIT_BAR(0);
  DMA_K(3, 0); DMA_V(1, SLOTB);
  ROT();
  kload8(kf, kp0 + sl_cur);
  WAIT_BAR(2);
  s16x4 vlo[8], vhi[8]; u32x4 pw0, pw1, pw2, pw3;
  #define PKW(P, B) cvtpk_s(P[B], P[B + 1])
  #define PAF(k) __builtin_bit_cast(bf16x8, pw##k)
  #define VFR(i) (bf16x8){vlo[i][0], vlo[i][1], vlo[i][2], vlo[i][3], vhi[i][0], vhi[i][1], vhi[i][2], vhi[i][3]}
  #define PIN(x) asm volatile("" : "+v"(x))
  #define MX3(a, b, c) __builtin_fmaxf(__builtin_fmaxf((a), (b)), (c))
  #define GAPA(MF, A0, A1, A2, A3, W0, W1, PW) do { MF; sacc += A0; sacc += A1; sacc += A2; sacc += A3; PIN(sacc); W0; W1; PIN(PW); SBAR(); } while (0)
  #define EX(v) __builtin_amdgcn_exp2f(v)
  #define GAPB(MF, X, B) do { MF; X[B] = EX(X[B]); X[B + 1] = EX(X[B + 1]); X[B + 2] = EX(X[B + 2]); X[B + 3] = EX(X[B + 3]); PIN(X); SBAR(); } while (0)
  #define VRD(i) do { vlo[i] = vtr(vp_ + (((i) >> 2) * 4096 + ((i) & 3) * 1024)); vhi[i] = vtr(vp_ + (((i) >> 2) * 4096 + ((i) & 3) * 1024 + 512)); } while (0)
  #define KRD(G, j) do { if (G) { kload2(kf, kp0 + sl_next, j); SBAR(); } } while (0)
  #define STEP(C0, C1, P0, P1, t, GK, GV, GL) do { SBAR(); \
    const lds_cptr vp_ = vp0 + sl_prev; \
    VRD(0); SBAR(); float sacc = (P0[0] + P0[1]); \
    GAPA(C0 = __builtin_amdgcn_mfma_f32_32x32x16_bf16(kf[0], qr[0], negm, 0, 0, 0), P0[2], P0[3], P0[4], P0[5],     pw0[0] = PKW(P0, 0), pw0[1] = PKW(P0, 2), pw0); \
    VRD(4); SBAR(); GAPA(C1 = __builtin_amdgcn_mfma_f32_32x32x16_bf16(kf[1], qr[0], negm, 0, 0, 0), P0[6], P0[7], P0[8], P0[9],     pw0[2] = PKW(P0, 4), pw0[3] = PKW(P0, 6), pw0); \
    VRD(1); SBAR(); GAPA(C0 = __builtin_amdgcn_mfma_f32_32x32x16_bf16(kf[2], qr[1], C0, 0, 0, 0),   P0[10], P0[11], P0[12], P0[13], pw1[0] = PKW(P0, 8), pw1[1] = PKW(P0, 10), pw1); \
    VRD(5); SBAR(); GAPA(C1 = __builtin_amdgcn_mfma_f32_32x32x16_bf16(kf[3], qr[1], C1, 0, 0, 0),   P0[14], P0[15], P1[0], P1[1],   pw1[2] = PKW(P0, 12), pw1[3] = PKW(P0, 14), pw1); \
    VRD(2); SBAR(); GAPA(C0 = __builtin_amdgcn_mfma_f32_32x32x16_bf16(kf[4], qr[2], C0, 0, 0, 0),   P1[2], P1[3], P1[4], P1[5],     pw2[0] = PKW(P1, 0), pw2[1] = PKW(P1, 2), pw2); \
    VRD(6); SBAR(); GAPA(C1 = __builtin_amdgcn_mfma_f32_32x32x16_bf16(kf[5], qr[2], C1, 0, 0, 0),   P1[6], P1[7], P1[8], P1[9],     pw2[2] = PKW(P1, 4), pw2[3] = PKW(P1, 6), pw2); \
    VRD(3); SBAR(); GAPA(C0 = __builtin_amdgcn_mfma_f32_32x32x16_bf16(kf[6], qr[3], C0, 0, 0, 0),   P1[10], P1[11], P1[12], P1[13], pw3[0] = PKW(P1, 8), pw3[1] = PKW(P1, 10), pw3); \
    VRD(7); SBAR(); GAPA(C1 = __builtin_amdgcn_mfma_f32_32x32x16_bf16(kf[7], qr[3], C1, 0, 0, 0),   P1[14], P1[15], 0.f, 0.f,       pw3[2] = PKW(P1, 12), pw3[3] = PKW(P1, 14), pw3); \
    l_reg += sacc; \
    if (GK) { DMA_K((t) + 3, sl_cur); } if (GV) { DMA_V((t) + 1, sl_next); } \
    SBAR(); \
    GAPB(o[0] = __builtin_amdgcn_mfma_f32_32x32x16_bf16(PAF(0), VFR(0), o[0], 0, 0, 0), C0, 0); \
    GAPB(o[1] = __builtin_amdgcn_mfma_f32_32x32x16_bf16(PAF(0), VFR(4), o[1], 0, 0, 0), C0, 4); \
    KRD(GL, 0); GAPB(o[0] = __builtin_amdgcn_mfma_f32_32x32x16_bf16(PAF(1), VFR(1), o[0], 0, 0, 0), C0, 8); \
    KRD(GL, 1); GAPB(o[1] = __builtin_amdgcn_mfma_f32_32x32x16_bf16(PAF(1), VFR(5), o[1], 0, 0, 0), C0, 12); \
    KRD(GL, 2); GAPB(o[0] = __builtin_amdgcn_mfma_f32_32x32x16_bf16(PAF(2), VFR(2), o[0], 0, 0, 0), C1, 0); \
    KRD(GL, 3); GAPB(o[1] = __builtin_amdgcn_mfma_f32_32x32x16_bf16(PAF(2), VFR(6), o[1], 0, 0, 0), C1, 4); \
    GAPB(o[0] = __builtin_amdgcn_mfma_f32_32x32x16_bf16(PAF(3), VFR(3), o[0], 0, 0, 0), C1, 8); \
    GAPB(o[1] = __builtin_amdgcn_mfma_f32_32x32x16_bf16(PAF(3), VFR(7), o[1], 0, 0, 0), C1, 12); \
    } while (0)
  int t = 1;
  for (; t + 5 < NT; t += 2) {
    STEP(pB0, pB1, pA0, pA1, t, true, true, true);     WAIT_BAR(2); RESC(); ROT();
    STEP(pA0, pA1, pB0, pB1, t + 1, true, true, true); WAIT_BAR(2); RESC(); ROT();
  }
  #define ENDW(tt) do { if ((tt) + 3 < NT) { WAIT_BAR(2); } else if ((tt) + 2 < NT) { WAIT_BAR(1); } else { WAIT_BAR(0); } } while (0)
  for (; t + 1 < NT; t += 2) {
    STEP(pB0, pB1, pA0, pA1, t, (t + 3 < NT), (t + 1 < NT), (t + 1 < NT));         ENDW(t);     RESC(); ROT();
    STEP(pA0, pA1, pB0, pB1, t + 1, (t + 4 < NT), (t + 2 < NT), (t + 2 < NT));     ENDW(t + 1); RESC(); ROT();
  }
  STEP(pB0, pB1, pA0, pA1, NT - 1, false, false, false); RESC();
  { float sacc = pB0[0] + pB0[1]; _Pragma("unroll") for (int r = 2; r < 16; ++r) sacc += pB0[r]; _Pragma("unroll") for (int r = 0; r < 16; ++r) sacc += pB1[r]; l_reg += sacc;
    pw0 = (u32x4){PKW(pB0, 0), PKW(pB0, 2), PKW(pB0, 4), PKW(pB0, 6)}; pw1 = (u32x4){PKW(pB0, 8), PKW(pB0, 10), PKW(pB0, 12), PKW(pB0, 14)}; pw2 = (u32x4){PKW(pB1, 0), PKW(pB1, 2), PKW(pB1, 4), PKW(pB1, 6)}; pw3 = (u32x4){PKW(pB1, 8), PKW(pB1, 10), PKW(pB1, 12), PKW(pB1, 14)};
    SBAR(); pv(o, vb0 + sl_cur, PAF(0), PAF(1), PAF(2), PAF(3)); }
  #undef PKW
  #undef PAF
  #undef VFR
  #undef PIN
  #undef MX3
  #undef GAPA
  #undef GAPB
  #undef EX
  #undef VRD
  #undef KRD
  #undef STEP
  #undef ENDW
  { auto rr = __builtin_amdgcn_permlane32_swap(__float_as_uint(l_reg), __float_as_uint(l_reg), false, false); l_reg = __uint_as_float(rr[0]) + __uint_as_float(rr[1]); }
  if (hi == 0) wsf[32 + r32] = l_reg; asm volatile("s_waitcnt lgkmcnt(0)" ::: "memory");
  float rli[16];
  #pragma unroll
  for (int r = 0; r < 16; ++r) rli[r] = __builtin_amdgcn_rcpf(wsf[32 + crow(r, hi)]);
  bf16* Ow = Oh + (long)(q0 + wid * QBLK) * PO;
  const bf16* Zw = Zh + (long)(q0 + wid * QBLK) * PQ;
  { bf16* stg = (bf16*)(shm + LDS_OST) + wid * 2048;
    #pragma unroll
    for (int r = 0; r < 16; ++r) { const int orow = crow(r, hi);
      #pragma unroll
      for (int d0 = 0; d0 < 2; ++d0) stg[orow * 64 + d0 * 32 + r32] = __float2bfloat16(o[d0][r] * rli[r]); }
    asm volatile("s_waitcnt lgkmcnt(0)" ::: "memory");
    #pragma unroll
    for (int i = 0; i < 4; ++i) { const int row = i * 8 + (lane >> 3), ch = lane & 7; const u32x4 v = *(const u32x4*)(stg + row * 64 + ch * 8);
      const u32x4 z = *(const u32x4*)(Zw + (long)row * PQ + ch * 8); u32x4 w;
      #pragma unroll
      for (int e = 0; e < 4; ++e) w[e] = cvt_pk_bf16(bf_lo(v[e]) * silu_f(bf_lo(z[e])), bf_hi(v[e]) * silu_f(bf_hi(z[e])));
      *(u32x4*)(Ow + (long)row * PO + ch * 8) = w; } }
  asm volatile("s_waitcnt lgkmcnt(0)\n\ts_barrier" ::: "memory");
  #undef DMA_K
  #undef DMA_V
  #undef START
  #undef RESC
  #undef ROT
}
#undef WAIT_BAR
}

struct LA { f32x16 o0, o1; float m, l; };
__device__ __forceinline__ f32x16 zero16() { float z; asm volatile("v_mov_b32 %0, 0" : "=v"(z)); f32x16 v;
#pragma unroll
    for (int r = 0; r < 16; ++r) v[r] = z;
    return v; }
struct Frag { bf16x8 k[4], v[4]; };
struct TP { unsigned koff, voff; const LAS char* tp; int cb; const LAS char* tp2; };
__device__ __forceinline__ void la_loadK(Frag& f, const char* kb, const TP& t) {
#pragma unroll
    for (int d0 = 0; d0 < 4; ++d0) f.k[d0] = *(const bf16x8*)(kb + t.koff + d0 * 32);
}
struct VSG { const char* b;
    template <int V1> __device__ __forceinline__ void load(Frag& f, unsigned voff) const { const char* p = b + (long)(int)voff; const char* q = p + (size_t)16 * VTPP * 2;
        f.v[0] = *(const bf16x8*)(p); f.v[1] = *(const bf16x8*)(p + V1); f.v[2] = *(const bf16x8*)(q); f.v[3] = *(const bf16x8*)(q + V1); } };
constexpr int VSL_PITCH = 1296;
struct VSL { const LAS char* b;
    template <int V1> __device__ __forceinline__ void load(Frag& f, unsigned voff) const { const LAS char* p = b + voff; const LAS char* q = p + 32 * VSL_PITCH;
        f.v[0] = *(const LAS bf16x8*)(p); f.v[1] = *(const LAS bf16x8*)(p + V1); f.v[2] = *(const LAS bf16x8*)(q); f.v[3] = *(const LAS bf16x8*)(q + V1); } };
template <int TS4, int TG4> struct MBTab {
    __device__ __forceinline__ static float apply(const TP& t, int reg, float s) { return s + *(const LAS float*)(t.tp + (reg & 7) * TS4 + (reg >> 3) * TG4); }
    __device__ __forceinline__ static TP second(const TP& t) { TP b = t; b.tp = t.tp2; return b; }
};
template <int GI4, int GC> struct MBNa {
    __device__ __forceinline__ static float apply(const TP& t, int reg, float s) { const float b = *(const LAS float*)(t.tp + (reg & 7) * 4 + (reg >> 3) * GI4);
        return (unsigned)(t.cb + (reg & 7) + (reg >> 3) * GC) < 16u ? s + b : NEGBIG; }
    __device__ __forceinline__ static TP second(const TP& t) { TP b = t; b.tp = t.tp2; return b; }
};
template <int GI4> struct MBNaXM {
    __device__ __forceinline__ static float apply(const TP& t, int reg, float s) { const float b = *(const LAS float*)(t.tp + (reg & 7) * 4 + (reg >> 3) * GI4);
        const bool col = (unsigned)((int)(short)(t.cb & 0xffff) + (reg & 7)) < 16u, row = (t.cb >> (reg < 8 ? 16 : 17)) & 1; return (col && row) ? s + b : NEGBIG; }
    __device__ __forceinline__ static TP second(const TP& t) { TP b = t; b.tp = t.tp2; b.cb = (t.cb & 0xffff) | ((t.cb >> 4) & 0x30000); return b; }
};
template <class MB, int V1, class VS> __device__ __forceinline__ void la_step(LA& st, const bf16x8 (&qf)[4], Frag& f, const char* kb, const VS& vs, const TP& t, const TP& n) {
    f32x16 s = zero16();
#pragma unroll
    for (int d0 = 0; d0 < 4; ++d0) s = __builtin_amdgcn_mfma_f32_32x32x16_bf16(f.k[d0], qf[d0], s, 0, 0, 0);
    la_loadK(f, kb, n);
    float mx = NEGBIG;
#pragma unroll
    for (int r = 0; r < 16; ++r) { s[r] = MB::apply(t, r, s[r]); mx = __builtin_fmaxf(mx, s[r]); }
    { auto rr = __builtin_amdgcn_permlane32_swap(__float_as_uint(mx), __float_as_uint(mx), false, false); mx = __builtin_fmaxf(__uint_as_float(rr[0]), __uint_as_float(rr[1])); }
    if (__any(mx > st.m)) { const float mn = __builtin_fmaxf(st.m, mx), alpha = __builtin_amdgcn_exp2f(st.m - mn); st.m = mn; st.l *= alpha; st.o0 *= alpha; st.o1 *= alpha; }
    float rs = 0.f;
#pragma unroll
    for (int r = 0; r < 16; ++r) { s[r] = __builtin_amdgcn_exp2f(s[r] - st.m); rs += s[r]; }
    st.l += rs;
    u32x4 p0, p1;
#pragma unroll
    for (int e = 0; e < 4; ++e) { p0[e] = cvt_pk_bf16(s[2 * e], s[2 * e + 1]); p1[e] = cvt_pk_bf16(s[8 + 2 * e], s[8 + 2 * e + 1]); }
    const bf16x8 pf0 = __builtin_bit_cast(bf16x8, p0), pf1 = __builtin_bit_cast(bf16x8, p1);
    st.o0 = __builtin_amdgcn_mfma_f32_32x32x16_bf16(f.v[0], pf0, st.o0, 0, 0, 0); st.o0 = __builtin_amdgcn_mfma_f32_32x32x16_bf16(f.v[1], pf1, st.o0, 0, 0, 0);
    st.o1 = __builtin_amdgcn_mfma_f32_32x32x16_bf16(f.v[2], pf0, st.o1, 0, 0, 0); st.o1 = __builtin_amdgcn_mfma_f32_32x32x16_bf16(f.v[3], pf1, st.o1, 0, 0, 0);
    vs.template load<V1>(f, n.voff);
}
template <int TS4, int TG4> struct MBTabM {
    __device__ __forceinline__ static float apply(const TP& t, int reg, float s) { const float v = s + *(const LAS float*)(t.tp + (reg & 7) * TS4 + (reg >> 3) * TG4);
        return (t.cb & (reg < 8 ? 1 : 2)) ? NEGBIG : v; }
    __device__ __forceinline__ static TP second(const TP& t) { TP b = t; b.tp = t.tp2; return b; }
};
typedef MBTabM<64, 1024> MB_D4M;
typedef MBTab<64, 8> MB_D1; typedef MBTab<4, 64> MB_A; typedef MBNa<64, 16> MB_B; typedef MBNa<1024, 0> MB_BX; typedef MBNaXM<1024> MB_BXM; typedef MBTab<64, 1024> MB_D16; typedef MBTab<64, 32> MB_D4;
#define LA_RUN(NT, TILE, MB, V1, KB, VS_) do { Frag f_; { const TP t0_ = TILE(0); la_loadK(f_, KB, t0_); (VS_).template load<V1>(f_, t0_.voff); } \
    _Pragma("unroll 1") for (int i_ = 0; i_ < (NT); ++i_) { const TP t_ = TILE(i_); const TP n_ = TILE(i_ + 1 < (NT) ? i_ + 1 : i_); la_step<MB, V1>(st, qf, f_, KB, VS_, t_, n_); } } while (0)
template <class MB> __device__ __forceinline__ void la_soft(LA& st, f32x16& s, const TP& t, bf16x8& pf0, bf16x8& pf1) {
    float mx = NEGBIG;
#pragma unroll
    for (int r = 0; r < 16; ++r) { s[r] = MB::apply(t, r, s[r]); mx = __builtin_fmaxf(mx, s[r]); }
    { auto rr = __builtin_amdgcn_permlane32_swap(__float_as_uint(mx), __float_as_uint(mx), false, false); mx = __builtin_fmaxf(__uint_as_float(rr[0]), __uint_as_float(rr[1])); }
    if (__any(mx > st.m)) { const float mn = __builtin_fmaxf(st.m, mx), alpha = __builtin_amdgcn_exp2f(st.m - mn); st.m = mn; st.l *= alpha; st.o0 *= alpha; st.o1 *= alpha; }
    float rs = 0.f;
#pragma unroll
    for (int r = 0; r < 16; ++r) { s[r] = __builtin_amdgcn_exp2f(s[r] - st.m); rs += s[r]; }
    st.l += rs;
    u32x4 p0, p1;
#pragma unroll
    for (int e = 0; e < 4; ++e) { p0[e] = cvt_pk_bf16(s[2 * e], s[2 * e + 1]); p1[e] = cvt_pk_bf16(s[8 + 2 * e], s[8 + 2 * e + 1]); }
    pf0 = __builtin_bit_cast(bf16x8, p0); pf1 = __builtin_bit_cast(bf16x8, p1);
}
template <class MB, int V1, class VS> __device__ __forceinline__ void la_step2(LA& sa, LA& sb, const bf16x8 (&qa)[4], const bf16x8 (&qb)[4], Frag& f, const char* kb, const VS& vs, const TP& t, const TP& n) {
    bf16x8 pa0, pa1;
    { f32x16 s0 = zero16();
#pragma unroll
      for (int d0 = 0; d0 < 4; ++d0) s0 = __builtin_amdgcn_mfma_f32_32x32x16_bf16(f.k[d0], qa[d0], s0, 0, 0, 0);
      la_soft<MB>(sa, s0, t, pa0, pa1); }
    f32x16 s1 = zero16();
#pragma unroll
    for (int d0 = 0; d0 < 4; ++d0) s1 = __builtin_amdgcn_mfma_f32_32x32x16_bf16(f.k[d0], qb[d0], s1, 0, 0, 0);
    la_loadK(f, kb, n);
    sa.o0 = __builtin_amdgcn_mfma_f32_32x32x16_bf16(f.v[0], pa0, sa.o0, 0, 0, 0); sa.o1 = __builtin_amdgcn_mfma_f32_32x32x16_bf16(f.v[2], pa0, sa.o1, 0, 0, 0);
    sa.o0 = __builtin_amdgcn_mfma_f32_32x32x16_bf16(f.v[1], pa1, sa.o0, 0, 0, 0); sa.o1 = __builtin_amdgcn_mfma_f32_32x32x16_bf16(f.v[3], pa1, sa.o1, 0, 0, 0);
    { bf16x8 pb0, pb1; const TP tb = MB::second(t);
      la_soft<MB>(sb, s1, tb, pb0, pb1);
      sb.o0 = __builtin_amdgcn_mfma_f32_32x32x16_bf16(f.v[0], pb0, sb.o0, 0, 0, 0); sb.o1 = __builtin_amdgcn_mfma_f32_32x32x16_bf16(f.v[2], pb0, sb.o1, 0, 0, 0);
      sb.o0 = __builtin_amdgcn_mfma_f32_32x32x16_bf16(f.v[1], pb1, sb.o0, 0, 0, 0); sb.o1 = __builtin_amdgcn_mfma_f32_32x32x16_bf16(f.v[3], pb1, sb.o1, 0, 0, 0); }
    vs.template load<V1>(f, n.voff);
}
#define LA_RUN2(NT, TILE, MB, V1, KB, VS_) do { Frag f_; { const TP t0_ = TILE(0); la_loadK(f_, KB, t0_); (VS_).template load<V1>(f_, t0_.voff); } \
    _Pragma("unroll 1") for (int i_ = 0; i_ < (NT); ++i_) { const TP t_ = TILE(i_); const TP n_ = TILE(i_ + 1 < (NT) ? i_ + 1 : i_); la_step2<MB, V1>(sa, sb, qa, qb, f_, KB, VS_, t_, n_); } } while (0)
__device__ __forceinline__ int o1_off(int rho, int ch) { return rho * 128 + (((ch + (rho >> 1) + (rho >> 4)) & 15) << 3); }

__device__ __forceinline__ int lam_of(int r32) { return (r32 & 0x13) | ((r32 & 4) << 1) | ((r32 & 8) >> 1); }

__device__ __forceinline__ void la_loadz(u32x2 (&z)[8], const bf16_t* zrow, int hi) {
#pragma unroll
    for (int db = 0; db < 2; ++db)
#pragma unroll
        for (int g = 0; g < 4; ++g) z[4 * db + g] = *(const u32x2*)(zrow + 32 * db + 8 * g + 4 * hi);
}
__device__ __forceinline__ void la_store(const LA& st, bool use_sink, float sink2, const u32x2 (&zv)[8], bf16_t* yrow, int hi) {
    float l = st.l; { auto rr = __builtin_amdgcn_permlane32_swap(__float_as_uint(l), __float_as_uint(l), false, false); l = __uint_as_float(rr[0]) + __uint_as_float(rr[1]); }
    float inv;
    if (use_sink) { const float m2 = fmaxf(st.m, sink2), a = __builtin_amdgcn_exp2f(st.m - m2); inv = a / (l * a + __builtin_amdgcn_exp2f(sink2 - m2)); }
    else inv = 1.f / l;
#pragma unroll
    for (int db = 0; db < 2; ++db)
#pragma unroll
        for (int g = 0; g < 4; ++g) { const int c = 32 * db + 8 * g + 4 * hi; const u32x2 z = zv[4 * db + g];
            const f32x16& o = db ? st.o1 : st.o0;
            u32x2 w; w.x = cvt_pk_bf16(o[4 * g] * inv * silu_f(bf_lo(z.x)), o[4 * g + 1] * inv * silu_f(bf_hi(z.x)));
            w.y = cvt_pk_bf16(o[4 * g + 2] * inv * silu_f(bf_lo(z.y)), o[4 * g + 3] * inv * silu_f(bf_hi(z.y)));
            *(u32x2*)(yrow + c) = w; }
}

#define XB_TMO      128
#define XB_XCNT(j)  (256  + 64 * (j))
#define XB_XSUB(j)  (1280 + 64 * (j))
#define XB_XGEN(j)  (2304 + 64 * (j))
#define XB_TOP      3328
#define XB_TOPGEN   3392
#define XCD_BAR_WORDS 3456
#define XB_SPIN_CAP (1u << 18)

__device__ __forceinline__ unsigned xb_ld(unsigned* p)              { return __hip_atomic_load(p, __ATOMIC_RELAXED, __HIP_MEMORY_SCOPE_AGENT); }
__device__ __forceinline__ unsigned xb_add(unsigned* p, unsigned v) { return __hip_atomic_fetch_add(p, v, __ATOMIC_RELAXED, __HIP_MEMORY_SCOPE_AGENT); }
__device__ __forceinline__ unsigned xb_xcc_id() { return (unsigned)__builtin_amdgcn_s_getreg((3 << 11) | 20) & 0xFu; }
#define XB_SPIN(cond, bar) do { unsigned _sp = 0; while (cond) { __builtin_amdgcn_s_sleep(1); \
    if ((++_sp & 255u) == 0u) { if (xb_ld(&(bar)[XB_TMO])) break; if (_sp > XB_SPIN_CAP) { atomicAdd(&(bar)[XB_TMO], 1u); break; } } } } while (0)

__device__ __forceinline__ unsigned xb_lane() { unsigned l = __builtin_amdgcn_mbcnt_hi(~0u, __builtin_amdgcn_mbcnt_lo(~0u, 0u)); asm volatile("" : "+v"(l)); return l; }
struct XcdBarrier {
    unsigned* bar; unsigned x; unsigned lead;
    volatile LAS unsigned* st;
};

__device__ __forceinline__ XcdBarrier xcd_barrier_post(unsigned* bar, volatile LAS unsigned* st, unsigned lead) {
    XcdBarrier b; b.bar = bar; b.x = xb_xcc_id(); b.st = st; b.lead = lead;
    if (lead != 0u && xb_lane() == 0u) (void)xb_add(&bar[XB_XCNT(b.x)], 1u);
    return b;
}
__device__ __forceinline__ void xcd_barrier_complete(unsigned* bar, unsigned x, unsigned& nloc, unsigned& nx) {
    const unsigned G = gridDim.x * gridDim.y * gridDim.z;
    unsigned sum, cnt, mine, sp = 0u;
    for (;;) {
        sum = 0u; cnt = 0u; mine = 0u;
#pragma unroll
        for (unsigned j = 0; j < 16; ++j) { const unsigned c = xb_ld(&bar[XB_XCNT(j)]); sum += c; cnt += (c > 0u) ? 1u : 0u; mine = (j == x) ? c : mine; }
        if (sum == G) break;
        __builtin_amdgcn_s_sleep(1);
        if ((++sp & 255u) == 0u) { if (xb_ld(&bar[XB_TMO])) break; if (sp > XB_SPIN_CAP) { atomicAdd(&bar[XB_TMO], 1u); break; } }
    }
    nloc = mine > 0u ? mine : 1u; nx = cnt > 0u ? cnt : 1u;
}

__device__ __forceinline__ void xcd_barrier(const XcdBarrier& b) {
    asm volatile("s_waitcnt vmcnt(0)" ::: "memory");
    __syncthreads();
    if (b.lead != 0u && xb_lane() == 0u) {
        unsigned* bar = b.bar;
        __builtin_amdgcn_s_waitcnt(0);
        unsigned nloc = b.st[0], nx = b.st[1];
        if (nloc == 0u) { xcd_barrier_complete(bar, b.x, nloc, nx); b.st[0] = nloc; b.st[1] = nx; }
        const unsigned old = xb_add(&bar[XB_XSUB(b.x)], 1u);
        const unsigned gen = old / nloc;
        if (old + 1u == (gen + 1u) * nloc) {
            __builtin_amdgcn_fence(__ATOMIC_RELEASE, "agent");
            asm volatile("s_waitcnt vmcnt(0)" ::: "memory");
            const unsigned og = xb_add(&bar[XB_TOP], 1u);
            const unsigned tg = og / nx;
            if (og + 1u == (tg + 1u) * nx) xb_add(&bar[XB_TOPGEN], 1u);
            else XB_SPIN(xb_ld(&bar[XB_TOPGEN]) == tg, bar);
            __builtin_amdgcn_fence(__ATOMIC_ACQUIRE, "agent");
            xb_add(&bar[XB_XGEN(b.x)], 1u);
            asm volatile("s_waitcnt vmcnt(0)" ::: "memory");
        } else {
            XB_SPIN(xb_ld(&bar[XB_XGEN(b.x)]) == gen, bar);
            __builtin_amdgcn_fence(__ATOMIC_ACQUIRE, "agent");
            asm volatile("s_waitcnt vmcnt(0)" ::: "memory");
        }
    }
    __syncthreads();
}

__device__ __forceinline__ void convert_items(const float* W, bf16_t* WT, const int N, const int permute, LAS float* scr, const int lane, const int first, const int stride, const int nitems) {
    for (int item = first; item < nitems; item += stride) {
        const int nblk = N / 32, kb = item / nblk, nb = item % nblk, k0 = 64 * kb, n0 = 32 * nb;
        int d0 = n0;
        if (permute && n0 >= 13 * 256 && n0 < 16 * 256) { const int o = n0 & 255, wc = o >> 6, bj = (o >> 5) & 1; d0 = (n0 & ~255) + 128 * bj + 32 * wc; }
        { float tv[32];
#pragma unroll
        for (int i = 0; i < 32; ++i) { const int kk = 2 * i + (lane >> 5); tv[i] = __builtin_nontemporal_load(W + (size_t)(k0 + kk) * N + n0 + (lane & 31)); }
#pragma unroll
        for (int i = 0; i < 32; ++i) { const int kk = 2 * i + (lane >> 5); scr[kk * 33 + (lane & 31)] = tv[i]; } }
        asm volatile("s_waitcnt lgkmcnt(0)" ::: "memory");
        const int c = lane & 7;
#pragma unroll
        for (int j = 0; j < 4; ++j) { const int n = (lane >> 3) + 8 * j; const LAS float* s = scr + (8 * c) * 33 + n;
            u32x4 o; o.x = cvt_pk_bf16(s[0 * 33], s[1 * 33]); o.y = cvt_pk_bf16(s[2 * 33], s[3 * 33]); o.z = cvt_pk_bf16(s[4 * 33], s[5 * 33]); o.w = cvt_pk_bf16(s[6 * 33], s[7 * 33]);
            *(u32x4*)(WT + (size_t)(d0 + n) * DMODEL + k0 + 8 * c) = o; }
        asm volatile("s_waitcnt lgkmcnt(0)" ::: "memory");
    }
}
struct Args { const float* in[13]; float* out; unsigned char* ws; int ph_lo, ph_hi; };

__global__ void __launch_bounds__(NWAVES * 64, 2) mk_fwd(Args args) {
    extern __shared__ __attribute__((aligned(16))) unsigned char lds_raw[];
    LAS unsigned char* lds = (LAS unsigned char*)lds_raw;
    const int G = gridDim.x;
#define PHASE_BEGIN \
    int tid = wave_s * 64 + (int)xb_lane(); asm volatile("" : "+v"(tid)); int bx = blockIdx.x; asm volatile("" : "+s"(bx)); \
    const int lane = tid & 63, wave = __builtin_amdgcn_readfirstlane(tid >> 6); \
    int Gp_ = G; asm volatile("" : "+s"(Gp_)); const int vcu = (Gp_ % 8 == 0) ? (bx % 8) * (Gp_ / 8) + bx / 8 : bx; const int gw = vcu * NWAVES + wave, NGW = G * NWAVES; \
    size_t zoff_ = 0; asm volatile("" : "+s"(zoff_)); unsigned char* ws = args.ws + zoff_; \
    const Args* ka_ = (const Args*)((const char*)__builtin_amdgcn_kernarg_segment_ptr() + zoff_); \
    const float* x_in = ka_->in[0]; const float* c_in = ka_->in[1]; const float* w_ada = ka_->in[2]; const float* b_ada = ka_->in[3]; const float* norm_w = ka_->in[4]; \
    const float* w_in = ka_->in[5]; const float* w_out = ka_->in[6]; const float* attn_sink = ka_->in[7]; const float* na_rpb = ka_->in[8]; \
    const float* q_norm_w = ka_->in[9]; const float* k_norm_w = ka_->in[10]; const float* t5_table = ka_->in[11]; const float* final_norm_w = ka_->in[12]; float* out_p = ka_->out; \
    (void)x_in; (void)c_in; (void)w_ada; (void)b_ada; (void)norm_w; (void)w_in; (void)w_out; (void)attn_sink; (void)na_rpb; (void)q_norm_w; (void)k_norm_w; (void)t5_table; (void)final_norm_w; (void)out_p; \
    float* MODV = (float*)(ws + WS_MODV); float* TABA = (float*)(ws + WS_TABA); float* TABD = (float*)(ws + WS_TABD); float* CS = (float*)(ws + WS_CS); \
    bf16_t* WINT = (bf16_t*)(ws + WS_WINT); bf16_t* WOUTT = (bf16_t*)(ws + WS_WOUTT); bf16_t* Hb = (bf16_t*)(ws + WS_H); bf16_t* PROJ = (bf16_t*)(ws + WS_PROJ); \
    bf16_t* VTA = (bf16_t*)(ws + WS_VTA); bf16_t* VTB = (bf16_t*)(ws + WS_VTB); bf16_t* VTD = (bf16_t*)(ws + WS_VTD); bf16_t* Yb = (bf16_t*)(ws + WS_Y); float* XR = (float*)(ws + WS_XR); \
    (void)lane; (void)wave; (void)gw; (void)NGW; (void)MODV; (void)TABA; (void)TABD; (void)CS; (void)WINT; (void)WOUTT; (void)Hb; (void)PROJ; (void)VTA; (void)VTB; (void)VTD; (void)Yb; (void)XR;
    const int lo = args.ph_lo, hi_ph = args.ph_hi;
#define IN(k) (lo <= (k) && (k) < hi_ph)
    volatile LAS unsigned* bst = (volatile LAS unsigned*)(lds + 131072 + 64);
    const int wave_s = __builtin_amdgcn_readfirstlane((int)threadIdx.x >> 6);
    if (threadIdx.x < 2) bst[threadIdx.x] = 0u;
    __syncthreads();
    const bool one_launch = (lo == 0 && hi_ph == 18);
    const XcdBarrier xbar = xcd_barrier_post((unsigned*)args.ws, bst, (wave_s == 0) ? 1u : 0u);
    (void)one_launch;
#define SEAM(k) do { if (IN(k) && IN((k) + 1)) { if (hi_ph > 1000) cg::this_grid().sync(); else { XcdBarrier xb_ = xbar; unsigned x_ = __builtin_amdgcn_readfirstlane(xb_.x), l_ = __builtin_amdgcn_readfirstlane(xb_.lead); asm volatile("" : "+s"(x_), "+s"(l_)); xb_.x = x_; xb_.lead = l_; xcd_barrier(xb_); } } } while (0)

    if (IN(0)) {
        PHASE_BEGIN
        {
            constexpr int I_IN = (DMODEL / 64) * (NIN / 32);
            convert_items(w_in, WINT, NIN, 1, (LAS float*)(lds + wave * 16384), lane, gw, NGW, I_IN);
        }
        __syncthreads();
        {
            LAS float* cond = (LAS float*)lds; LAS float* red = cond + 2048;
            for (int i = tid; i < 2048; i += 512) cond[i] = silu_f(c_in[i]);
            __syncthreads();
            for (int it = vcu; it < DEPTH * 192; it += G) { const int l = it / 192, c0 = (it % 192) * 32;
                const float* wp = w_ada + (size_t)l * DMODEL * 6144 + c0 + (lane & 31); const int kofs = 2 * wave + (lane >> 5);
                float a0 = 0.f, a1 = 0.f, a2 = 0.f, a3 = 0.f;
#pragma unroll 1
                for (int j = 0; j < 128; j += 16) {
                    float wv[16];
#pragma unroll
                    for (int q = 0; q < 16; ++q) wv[q] = __builtin_nontemporal_load(wp + (size_t)(16 * (j + q) + kofs) * 6144);
#pragma unroll
                    for (int q = 0; q < 16; q += 4) { a0 += cond[16 * (j + q) + kofs] * wv[q]; a1 += cond[16 * (j + q + 1) + kofs] * wv[q + 1];
                        a2 += cond[16 * (j + q + 2) + kofs] * wv[q + 2]; a3 += cond[16 * (j + q + 3) + kofs] * wv[q + 3]; }
                }
                red[(2 * wave + (lane >> 5)) * 32 + (lane & 31)] = (a0 + a1) + (a2 + a3);
                __syncthreads();
                if (tid < 32) { float s = b_ada[l * 6144 + c0 + tid];
#pragma unroll
                    for (int p = 0; p < 16; ++p) s += red[p * 32 + tid];
                    MODV[l * 6144 + c0 + tid] = s; }
                __syncthreads();
            }
        }
        { const int gt = vcu * 512 + tid, NT_ = G * 512;
            for (int i = gt; i < SEQ * 32; i += NT_) { const int t = i >> 5, p = i & 31; const int fi = p & 15; const float pos = (p < 16) ? (float)(t >> 6) : (float)(t & 63);
                const float inv = powf(10000.f, -(float)(2 * fi) / 32.f); const float ang = pos * inv; float sn, cs; sincosf(ang, &sn, &cs); CS[2 * i] = cs; CS[2 * i + 1] = sn; }
            for (int i = gt; i < 8 * TABA_N + 8 * TABD_N; i += NT_) {
                int h, rel; float* dst;
                if (i < 8 * TABA_N) { h = i / TABA_N; rel = i % TABA_N - TABA_C; dst = TABA + i; } else { const int j = i - 8 * TABA_N; h = 8 + j / TABD_N; rel = j % TABD_N - TABD_C; dst = TABD + j; }
                const int n = rel < 0 ? -rel : rel; const float xf = (float)(n > 8 ? n : 8) / 8.f;
                int big = 8 + (int)(logf(xf) / 4.852030263919617f * 8.f); big = big < 15 ? big : 15;
                const int bucket = (rel > 0 ? 16 : 0) + (n < 8 ? n : big);
                *dst = t5_table[bucket * 16 + h] * LOG2E; }
        }
    }
    SEAM(0);

#pragma unroll 1
    for (int l = 0; l < DEPTH; ++l) {
        const int pb = 1 + 4 * l;
        if (IN(pb)) {
            PHASE_BEGIN
            const float* xcur = (l == 0) ? x_in : XR;
            LAS float* gL = (LAS float*)lds; LAS float* sL = gL + 2048;
            for (int i = tid; i < 2048; i += 512) { gL[i] = norm_w[l * 2048 + i] * (1.f + MODV[l * 6144 + 2048 + i]); sL[i] = MODV[l * 6144 + i]; }
            __syncthreads();
            for (int m = gw; m < SEQ; m += NGW) {
                const f32x4* xr = (const f32x4*)(xcur + (size_t)m * DMODEL) + lane;
                f32x4 v[8]; float s = 0.f;
#pragma unroll
                for (int j = 0; j < 8; ++j) { v[j] = xr[64 * j]; s += (v[j][0] * v[j][0] + v[j][1] * v[j][1]) + (v[j][2] * v[j][2] + v[j][3] * v[j][3]); }
                const float rstd = __builtin_amdgcn_rsqf(wave_sum(s) * (1.f / DMODEL) + EPS);
                u32x2* o8 = (u32x2*)(Hb + (size_t)m * DMODEL) + lane;
#pragma unroll
                for (int j = 0; j < 8; ++j) { const f32x4 g = *(const LAS f32x4*)(gL + 4 * lane + 256 * j), sh = *(const LAS f32x4*)(sL + 4 * lane + 256 * j);
                    const f32x4 y = v[j] * rstd * g + sh; u32x2 w; w.x = cvt_pk_bf16(y[0], y[1]); w.y = cvt_pk_bf16(y[2], y[3]); o8[64 * j] = w; }
            }
            __syncthreads();
        }
        SEAM(pb);
        if (IN(pb + 1)) {
            PHASE_BEGIN
            pg8::SchedIn S{(const char*)Hb, (const char*)(WINT + (size_t)l * NIN * DMODEL), G, bx};
            pg8::EpiIn E{PROJ, VTA, VTB, VTD, CS, q_norm_w + l * 64, k_norm_w + l * 64};
            pg8::gemm_phase<pg8::EpiIn, pg8::SchedIn>(tid, lds, DMODEL, S, E);
            const int first_idle = 1728 - 6 * G;
            if (G == 256 ? (bx >= first_idle) : true) {
                const int nidle = (G == 256) ? (G - first_idle) : G, me = (G == 256) ? (bx - first_idle) : bx;
                LAS float* scr = (LAS float*)(lds + wave * 16384);
                constexpr int I_IN = (DMODEL / 64) * (NIN / 32), I_OUT = (DMODEL / 64) * (DMODEL / 32);
                convert_items(w_out + (size_t)l * DMODEL * DMODEL, WOUTT + (size_t)l * DMODEL * DMODEL, DMODEL, 0, scr, lane, me * NWAVES + wave, nidle * NWAVES, I_OUT);
                if (l + 1 < DEPTH) convert_items(w_in + (size_t)(l + 1) * DMODEL * NIN, WINT + (size_t)(l + 1) * NIN * DMODEL, NIN, 1, scr, lane, me * NWAVES + wave, nidle * NWAVES, I_IN);
            }
        }
        SEAM(pb + 1);
        if (IN(pb + 2)) {
            PHASE_BEGIN
            {
                const int h = vcu >> 5;
                float mq = __builtin_fabsf(q_norm_w[l * 64 + lane]), mk = __builtin_fabsf(k_norm_w[l * 64 + lane]);
#pragma unroll
                for (int o_ = 1; o_ < 64; o_ <<= 1) { mq = __builtin_fmaxf(mq, __shfl_xor(mq, o_)); mk = __builtin_fmaxf(mk, __shfl_xor(mk, o_)); }
                const float mfix = __int_as_float(__builtin_amdgcn_readfirstlane(__float_as_int(8.f * mq * mk * LOG2E * 1.02f)));
                for (int u = 0; u < 2; ++u) { const int qb = (vcu & 31) * 2 + u;
                    attn_body::attn_unit<8>(tid, mfix, qb * 256, SEQ / 64, (const attn_body::bf16*)(PROJ + C_QC + h * 64), (const attn_body::bf16*)(PROJ + C_KC + (h >> 2) * 64), (const attn_body::bf16*)(PROJ + C_VC + (h >> 2) * 64),
                                            (const attn_body::bf16*)(PROJ + C_ZC + h * 64), (attn_body::bf16*)(Yb + 1024 + h * 64), (long)PP, (long)DMODEL, (char*)lds_raw); }
            }
            __syncthreads();
        }
        if (IN(pb + 2)) {
            PHASE_BEGIN
            const int h = vcu >> 5, v32 = vcu & 31;
            LAS float* tabA = (LAS float*)lds; LAS float* tabD1 = tabA + TABA_N; LAS float* tabD4 = tabD1 + TABA_N; LAS float* tabD16 = tabD4 + 2052; LAS float* tabNEG = tabD16 + 3076; LAS float* tabB = tabNEG + 512;
            LAS unsigned char* VIM = lds + 36864;
            LAS unsigned char* O1 = VIM; LAS float* LSE1 = (LAS float*)(VIM + 65536);
            {
                float vA = 0.f, vD1 = 0.f, v4[5], v16[7], vB[4]; u32x4 wv[12];
                if (tid < TABA_N) { const int rel = tid - TABA_C; vA = TABA[h * TABA_N + tid]; vD1 = TABD[h * TABD_N + TABD_C + rel]; }
#pragma unroll
                for (int k = 0; k < 5; ++k) { const int i = tid + 512 * k; v4[k] = (i < 2049) ? TABD[h * TABD_N + TABD_C + i - 1024] : 0.f; }
#pragma unroll
                for (int k = 0; k < 7; ++k) { const int i = tid + 512 * k; v16[k] = (i < TABD_N) ? TABD[h * TABD_N + i] : 0.f; }
#pragma unroll
                for (int k = 0; k < 4; ++k) { const int i = tid + 512 * k; const int r = i >> 7, c = (i & 127) - 64 + 15; vB[k] = (i < 15 * 128 && c >= 0 && c < 31) ? na_rpb[((l * 8 + h) * 15 + r) * 31 + c] * LOG2E : 0.f; }
#pragma unroll
                for (int k = 0; k < 12; ++k) { const int p = tid + 512 * k; const int pc = p % 6, c = (p / 6) & 15, d = p / 96; const int s8 = 32 * v32 - 8 + 8 * pc;
                    wv[k] = (u32x4){0u, 0u, 0u, 0u}; if (s8 >= 0 && s8 < 1024) wv[k] = *(const u32x4*)(VTD + vt_off(h * 64 + d, c * 1024 + s8)); }
                if (tid < TABA_N) { const int rel = tid - TABA_C; tabA[tid] = (rel >= -128 && rel <= 128) ? vA : NEGBIG; tabD1[tid] = (rel >= -64 && rel <= 64) ? vD1 : NEGBIG; }
#pragma unroll
                for (int k = 0; k < 5; ++k) { const int i = tid + 512 * k; const int rel = i - 1024; if (i < 2049) tabD4[i] = (rel >= -256 && rel <= 256) ? v4[k] : NEGBIG; }
#pragma unroll
                for (int k = 0; k < 7; ++k) { const int i = tid + 512 * k; const int rel = i - TABD_C; if (i < TABD_N) tabD16[i] = (rel >= -1024 && rel <= 1024) ? v16[k] : NEGBIG; }
                tabNEG[tid] = NEGBIG;
#pragma unroll
                for (int k = 0; k < 4; ++k) { const int i = tid + 512 * k; if (i < 15 * 128) tabB[i] = vB[k]; }
#pragma unroll
                for (int k = 0; k < 12; ++k) { const int p = tid + 512 * k; const int pc = p % 6, c = (p / 6) & 15, d = p / 96;
                    LAS unsigned short* row = (LAS unsigned short*)(VIM + d * VSL_PITCH);
#pragma unroll
                    for (int j = 0; j < 8; ++j) { const int tl = 128 * pc - 64 + 16 * j + c; const unsigned e = (j & 1) ? (wv[k][j >> 1] >> 16) : (wv[k][j >> 1] & 0xffffu); if (tl >= 0 && tl < 640) row[tl] = (unsigned short)e; } }
            }
            __syncthreads();
            const int r32 = lane & 31, hi = lane >> 5, lam = lam_of(r32);
            const LAS char* negp = (const LAS char*)tabNEG;
            const char* PB = (const char*)PROJ;
            {
                const int tl0 = 64 * wave, q0 = 512 * v32 + tl0, tqa = q0 + r32, tqb = tqa + 32;
                bf16x8 qa[4], qb[4]; const bf16_t* qp = PROJ + (size_t)tqa * PP + C_QD + h * 64 + 8 * hi;
#pragma unroll
                for (int d0 = 0; d0 < 4; ++d0) { qa[d0] = *(const bf16x8*)(qp + 16 * d0); qb[d0] = *(const bf16x8*)(qp + (size_t)32 * PP + 16 * d0); }
                LA sa, sb; sa.o0 = zero16(); sa.o1 = sa.o0; sa.m = NEGBIG; sa.l = 0.f; sb.o0 = zero16(); sb.o1 = sb.o0; sb.m = NEGBIG; sb.l = 0.f;
                const unsigned kc = (unsigned)(C_KD + h * 64 + 8 * hi);
                const VSL vs{(const LAS char*)VIM};
                auto tile = [&](int i) -> TP { const int t0r = q0 - 64 + 32 * i; const bool ok = t0r >= 0 && t0r < SEQ; const int t0 = ok ? t0r : q0; TP t;
                    t.koff = ((unsigned)(t0 + lam) * PP + kc) * 2u; t.voff = (unsigned)(r32 * VSL_PITCH + (tl0 + 32 * i + 8 * hi) * 2);
                    t.tp = (ok && i <= 4) ? (const LAS char*)(tabD1 + (TABA_C + t0 + 8 * hi - tqa)) : negp;
                    t.tp2 = (ok && i >= 1) ? (const LAS char*)(tabD1 + (TABA_C + t0 + 8 * hi - tqb)) : negp; t.cb = 0; return t; };
                LA_RUN2(6, tile, MB_A, 32, PB, vs);
                __syncthreads();
#pragma unroll
                for (int w2 = 0; w2 < 2; ++w2) { const LA& st = w2 ? sb : sa;
                    float lt = st.l; { auto rr = __builtin_amdgcn_permlane32_swap(__float_as_uint(lt), __float_as_uint(lt), false, false); lt = __uint_as_float(rr[0]) + __uint_as_float(rr[1]); }
                    const float inv = 1.f / lt; const int rho = tl0 + 32 * w2 + r32;
                    if (hi == 0) LSE1[rho] = st.m + __builtin_amdgcn_logf(lt);
#pragma unroll
                    for (int db = 0; db < 2; ++db)
#pragma unroll
                        for (int g = 0; g < 4; ++g) { const f32x16& o = db ? st.o1 : st.o0; u32x2 w; w.x = cvt_pk_bf16(o[4 * g] * inv, o[4 * g + 1] * inv); w.y = cvt_pk_bf16(o[4 * g + 2] * inv, o[4 * g + 3] * inv);
                            *(LAS u32x2*)(O1 + o1_off(rho, 8 * db + 2 * g + hi)) = w; } }
            }
            {
                const int q0 = 64 * (v32 * 8 + wave), tqa = q0 + r32, tqb = tqa + 32, kvh = h >> 2;
                bf16x8 qa[4], qb[4]; const bf16_t* qp = PROJ + (size_t)tqa * PP + C_QA + h * 64 + 8 * hi;
#pragma unroll
                for (int d0 = 0; d0 < 4; ++d0) { qa[d0] = *(const bf16x8*)(qp + 16 * d0); qb[d0] = *(const bf16x8*)(qp + (size_t)32 * PP + 16 * d0); }
                LA sa, sb; sa.o0 = zero16(); sa.o1 = sa.o0; sa.m = NEGBIG; sa.l = 0.f; sb.o0 = zero16(); sb.o1 = sb.o0; sb.m = NEGBIG; sb.l = 0.f;
                u32x2 za[8], zb[8]; la_loadz(za, PROJ + (size_t)tqa * PP + C_ZA + h * 64, hi); la_loadz(zb, PROJ + (size_t)tqb * PP + C_ZA + h * 64, hi);
                const int vd = kvh * 64 + r32; const unsigned kc = (unsigned)(C_KA + kvh * 64 + 8 * hi);
                const VSG vs{(const char*)VTA};
                auto tile = [&](int i) -> TP { const int t0r = q0 - 128 + 32 * i; const bool ok = t0r >= 0 && t0r < SEQ; const int t0 = ok ? t0r : q0; TP t;
                    t.koff = ((unsigned)(t0 + lam) * PP + kc) * 2u; t.voff = (unsigned)(vt_off(vd, t0 + 8 * hi) * 2);
                    t.tp = (ok && i <= 8) ? (const LAS char*)(tabA + (TABA_C + t0 + 8 * hi - tqa)) : negp;
                    t.tp2 = (ok && i >= 1) ? (const LAS char*)(tabA + (TABA_C + t0 + 8 * hi - tqb)) : negp; t.cb = 0; return t; };
                LA_RUN2(10, tile, MB_A, 32, PB, vs);
                const float sk2 = attn_sink[l * 8 + h] * LOG2E;
                la_store(sa, true, sk2, za, Yb + (size_t)tqa * DMODEL + h * 64, hi);
                la_store(sb, true, sk2, zb, Yb + (size_t)tqb * DMODEL + h * 64, hi);
            }
            {
                const int qh = wave & 1, qrow = 8 * v32 + 2 * (wave >> 1), qc = 32 * qh + r32, tqa = 64 * qrow + qc, tqb = tqa + 64;
                int rsa = qrow - 4; rsa = rsa < 0 ? 0 : (rsa > 248 ? 248 : rsa); int rsb = qrow - 3; rsb = rsb < 0 ? 0 : (rsb > 248 ? 248 : rsb); int cs = qc - 8; cs = cs < 0 ? 0 : (cs > 48 ? 48 : cs);
                bf16x8 qa[4], qb[4]; const bf16_t* qp = PROJ + (size_t)tqa * PP + C_QB + h * 64 + 8 * hi;
#pragma unroll
                for (int d0 = 0; d0 < 4; ++d0) { qa[d0] = *(const bf16x8*)(qp + 16 * d0); qb[d0] = *(const bf16x8*)(qp + (size_t)64 * PP + 16 * d0); }
                LA sa, sb; sa.o0 = zero16(); sa.o1 = sa.o0; sa.m = NEGBIG; sa.l = 0.f; sb.o0 = zero16(); sb.o1 = sb.o0; sb.m = NEGBIG; sb.l = 0.f;
                const int vd = h * 64 + r32; const unsigned kc = (unsigned)(C_KB + h * 64 + 8 * hi);
                const VSG vs{(const char*)VTB};
                const LAS char* bb0 = (const LAS char*)(tabB + ((7 - qrow) * 128 + 32 * qh + 8 * hi - qc + 64));
                const int cbr = 32 * qh + 8 * hi - cs;
                auto tile = [&](int i) -> TP { const int kr = rsa + i, krc = kr > 255 ? 255 : kr, t0 = 64 * krc + 32 * qh; const bool va = i <= 7, vb = kr >= rsb && kr < rsb + 8; TP t;
                    t.koff = ((unsigned)(t0 + lam) * PP + kc) * 2u; t.voff = (unsigned)(vt_off(vd, t0 + 8 * hi) * 2);
                    const LAS char* bp = bb0 + kr * 512;
                    t.tp = va ? bp : negp; t.tp2 = vb ? bp - 512 : negp; t.cb = cbr; return t; };
                LA_RUN2(9, tile, MB_B, 32, PB, vs);
                const int c0 = qh ? 24 : 32;
                {   LA& st = sa; const bf16x8 (&qf)[4] = qa;
                    auto tilx = [&](int i) -> TP { const int kr0 = rsa + 4 * i, t0 = 64 * kr0 + c0, tk = t0 + (lam & 7) + (lam >> 3) * 64; TP t;
                        t.koff = ((unsigned)tk * PP + kc) * 2u; t.voff = (unsigned)(vt_off(vd, t0 + hi * 64) * 2);
                        t.tp = (const LAS char*)(tabB + ((kr0 + hi - qrow + 7) * 128 + c0 - qc + 64)); t.cb = c0 - cs; t.tp2 = t.tp; return t; };
                    LA_RUN(2, tilx, MB_BX, 512, PB, vs); }
                {   LA& st = sb; const bf16x8 (&qf)[4] = qb;
                    auto tilx = [&](int i) -> TP { const int kr0 = rsb + 4 * i, t0 = 64 * kr0 + c0, tk = t0 + (lam & 7) + (lam >> 3) * 64; TP t;
                        t.koff = ((unsigned)tk * PP + kc) * 2u; t.voff = (unsigned)(vt_off(vd, t0 + hi * 64) * 2);
                        t.tp = (const LAS char*)(tabB + ((kr0 + hi - qrow - 1 + 7) * 128 + c0 - qc + 64)); t.cb = c0 - cs; t.tp2 = t.tp; return t; };
                    LA_RUN(2, tilx, MB_BX, 512, PB, vs); }
                u32x2 zv[8];
                la_loadz(zv, PROJ + (size_t)tqa * PP + C_ZB + h * 64, hi); la_store(sa, false, 0.f, zv, Yb + (size_t)tqa * DMODEL + 512 + h * 64, hi);
                la_loadz(zv, PROJ + (size_t)tqb * PP + C_ZB + h * 64, hi); la_store(sb, false, 0.f, zv, Yb + (size_t)tqb * DMODEL + 512 + h * 64, hi);
            }
            __syncthreads();
            {
                const int cA = (wave & 3) + 8 * (wave >> 2), cB = cA + 4, s0 = 32 * v32, tqa = 16 * (s0 + r32) + cA, tqb = tqa + 4;
                bf16x8 qa[4], qb[4]; const bf16_t* qp = PROJ + (size_t)tqa * PP + C_QD + h * 64 + 8 * hi;
#pragma unroll
                for (int d0 = 0; d0 < 4; ++d0) { qa[d0] = *(const bf16x8*)(qp + 16 * d0); qb[d0] = *(const bf16x8*)(qp + (size_t)4 * PP + 16 * d0); }
                LA sa, sb;
#pragma unroll
                for (int w2 = 0; w2 < 2; ++w2) { LA& st = w2 ? sb : sa; const int rho = 16 * r32 + (w2 ? cB : cA);
                    st.m = LSE1[rho]; st.l = hi ? 0.f : 1.f;
#pragma unroll
                    for (int db = 0; db < 2; ++db)
#pragma unroll
                        for (int g = 0; g < 4; ++g) { const u32x2 w = *(const LAS u32x2*)(O1 + o1_off(rho, 8 * db + 2 * g + hi));
                            if (db) { st.o1[4 * g] = bf_lo(w.x); st.o1[4 * g + 1] = bf_hi(w.x); st.o1[4 * g + 2] = bf_lo(w.y); st.o1[4 * g + 3] = bf_hi(w.y); }
                            else { st.o0[4 * g] = bf_lo(w.x); st.o0[4 * g + 1] = bf_hi(w.x); st.o0[4 * g + 2] = bf_lo(w.y); st.o0[4 * g + 3] = bf_hi(w.y); } } }
                const int vd = h * 64 + r32; const unsigned kc = (unsigned)(C_KD + h * 64 + 8 * hi);
                const VSG vs{(const char*)VTD};
                {
                    LA& st = sa; const bf16x8 (&qf)[4] = qa;
                    auto t16 = [&](int i) -> TP { const int sbr = s0 - 64 + 32 * i; const bool ok = sbr >= 0 && sbr < 1024; const int sb_ = ok ? sbr : s0;
                        const int t0 = 16 * sb_ + cA, tk = t0 + (lam & 7) * 16 + (lam >> 3) * 128; TP t;
                        t.koff = ((unsigned)tk * PP + kc) * 2u; t.voff = (unsigned)(vt_off(vd, cA * 1024 + sb_ + 8 * hi) * 2);
                        t.tp = ok ? (const LAS char*)(tabD16 + (TABD_C + t0 + hi * 128 - tqa)) : negp; t.cb = 0; t.tp2 = t.tp; return t; };
                    LA_RUN(5, t16, MB_D16, 32, PB, vs);
                }
                {
                    LA& st = sb; const bf16x8 (&qf)[4] = qb;
                    auto t16 = [&](int i) -> TP { const int sbr = s0 - 64 + 32 * i; const bool ok = sbr >= 0 && sbr < 1024; const int sb_ = ok ? sbr : s0;
                        const int t0 = 16 * sb_ + cB, tk = t0 + (lam & 7) * 16 + (lam >> 3) * 128; TP t;
                        t.koff = ((unsigned)tk * PP + kc) * 2u; t.voff = (unsigned)(vt_off(vd, cB * 1024 + sb_ + 8 * hi) * 2);
                        t.tp = ok ? (const LAS char*)(tabD16 + (TABD_C + t0 + hi * 128 - tqb)) : negp; t.cb = 0; t.tp2 = t.tp; return t; };
                    LA_RUN(5, t16, MB_D16, 32, PB, vs);
                }
                auto t4 = [&](int i) -> TP { const int cq = (cA & 3) + 4 * (i >> 1), sb_ = s0 - 16 + 32 * (i & 1);
                    const int t0 = 16 * sb_ + cq; int tk = t0 + (lam & 7) * 16 + (lam >> 3) * 128; tk = tk < 0 ? 0 : (tk > SEQ - 1 ? SEQ - 1 : tk); TP t;
                    t.koff = ((unsigned)tk * PP + kc) * 2u; t.voff = (unsigned)(vt_off(vd, cq * 1024 + sb_ + 8 * hi) * 2);
                    t.tp = (const LAS char*)(tabD4 + (1024 + t0 + hi * 128 - tqa)); t.tp2 = t.tp - 16; t.cb = (sb_ < 0 ? 1 : 0) | (sb_ + 32 > 1024 ? 2 : 0); return t; };
                LA_RUN2(8, t4, MB_D4M, 96, PB, vs);
                u32x2 zv[8];
                la_loadz(zv, PROJ + (size_t)tqa * PP + C_ZD + h * 64, hi); la_store(sa, false, 0.f, zv, Yb + (size_t)tqa * DMODEL + 1536 + h * 64, hi);
                la_loadz(zv, PROJ + (size_t)tqb * PP + C_ZD + h * 64, hi); la_store(sb, false, 0.f, zv, Yb + (size_t)tqb * DMODEL + 1536 + h * 64, hi);
            }
            __syncthreads();
        }
        SEAM(pb + 2);
        if (IN(pb + 3)) {
            PHASE_BEGIN
            const float* xcur = (l == 0) ? x_in : XR;
            pg8::SchedOut S{(const char*)Yb, (const char*)(WOUTT + (size_t)l * DMODEL * DMODEL), G, bx};
            pg8::EpiOut E{xcur, XR, MODV + l * 6144 + 4096};
            pg8::gemm_phase<pg8::EpiOut, pg8::SchedOut>(tid, lds, DMODEL, S, E);
        }
        SEAM(pb + 3);
    }
    if (IN(17)) {
        PHASE_BEGIN
        for (int m = gw; m < SEQ; m += NGW) {
            const f32x4* xr = (const f32x4*)(XR + (size_t)m * DMODEL) + lane;
            f32x4 v[8]; float s = 0.f;
#pragma unroll
            for (int j = 0; j < 8; ++j) { v[j] = xr[64 * j]; s += (v[j][0] * v[j][0] + v[j][1] * v[j][1]) + (v[j][2] * v[j][2] + v[j][3] * v[j][3]); }
            const float rstd = __builtin_amdgcn_rsqf(wave_sum(s) * (1.f / DMODEL) + EPS);
            f32x4* o = (f32x4*)(out_p + (size_t)m * DMODEL) + lane;
#pragma unroll
            for (int j = 0; j < 8; ++j) { const f32x4 g = *((const f32x4*)final_norm_w + lane + 64 * j); o[64 * j] = v[j] * rstd * g; }
        }
    }
#undef IN
#undef SEAM
}

extern "C" void kernel_launch(void* const* d_in, const int* in_sizes, int n_in, void* d_out, int out_size, void* d_ws, size_t ws_size, hipStream_t stream) {
    static int grid = 0;
    if (grid == 0) {
        if (n_in != 13 || ws_size < WS_END) { fprintf(stderr, "kernel_launch: unexpected inputs (n_in %d, ws %zu)\n", n_in, ws_size); grid = -1; return; }
        int dev = 0, cus = 0, per_cu = 0;
        (void)hipGetDevice(&dev); (void)hipDeviceGetAttribute(&cus, hipDeviceAttributeMultiprocessorCount, dev);
        (void)hipFuncSetAttribute((const void*)mk_fwd, hipFuncAttributeMaxDynamicSharedMemorySize, LDS_BYTES);
        (void)hipOccupancyMaxActiveBlocksPerMultiprocessor(&per_cu, (const void*)mk_fwd, NWAVES * 64, LDS_BYTES);
        (void)hipGetLastError();
        if (per_cu < 1) fprintf(stderr, "kernel_launch: occupancy query says %d blocks per CU\n", per_cu);
        grid = cus;
    }
    if (grid < 0) return;
    (void)hipMemsetAsync(d_ws, 0, 16384, stream);
    Args a{};
    for (int i = 0; i < 13; ++i) a.in[i] = (const float*)d_in[i];
    a.out = (float*)d_out; a.ws = (unsigned char*)d_ws;
#if MK_ONE_LAUNCH
    a.ph_lo = 0; a.ph_hi = 18;
    void* kargs[] = {&a};
    hipError_t e = hipLaunchCooperativeKernel((const void*)mk_fwd, dim3(grid), dim3(NWAVES * 64), kargs, LDS_BYTES, stream);
    if (e != hipSuccess) fprintf(stderr, "cooperative launch failed: %s (grid %d)\n", hipGetErrorString(e), grid);
#else
    for (int p = 0; p < 18; ++p) { a.ph_lo = p; a.ph_hi = p + 1; hipLaunchKernelGGL(mk_fwd, dim3(grid), dim3(NWAVES * 64), LDS_BYTES, stream, a); }
#endif
}
```

```cpp
#include <hip/hip_runtime.h>
#include <hip/hip_cooperative_groups.h>
#include <hip/hip_bf16.h>
#include <cstdio>
#include <cstdint>
#include <cmath>
namespace cg = cooperative_groups;

#ifndef MK_ONE_LAUNCH
#define MK_ONE_LAUNCH 1
#endif

#define LAS __attribute__((address_space(3)))
#define GAS __attribute__((address_space(1)))
typedef unsigned short bf16_t;
typedef short bf16x8 __attribute__((ext_vector_type(8)));
typedef float f32x4 __attribute__((ext_vector_type(4)));
typedef float f32x2 __attribute__((ext_vector_type(2)));
typedef float f32x16 __attribute__((ext_vector_type(16)));
typedef unsigned u32x4 __attribute__((ext_vector_type(4)));
typedef unsigned u32x2 __attribute__((ext_vector_type(2)));

constexpr int SEQ = 16384, DMODEL = 2048, NIN = 6656, DEPTH = 4;
constexpr int PP = NIN + 64;
constexpr int VTPP = 2 * SEQ + 64;
__host__ __device__ __forceinline__ int vt_off(int d, int p) { return (d >> 1) * VTPP + (p >> 5) * 64 + (d & 1) * 32 + (p & 31); }
constexpr int C_QA = 0, C_KA = 512, C_VA = 640, C_ZA = 768, C_QB = 1280, C_KB = 1792, C_VB = 2304, C_ZB = 2816;
constexpr int C_QC = 3328, C_KC = 3840, C_VC = 3968, C_ZC = 4096, C_QD = 4608, C_KD = 5120, C_VD = 5632, C_ZD = 6144;
constexpr float LOG2E = 1.4426950408889634f;
constexpr float C2 = 0.125f * LOG2E;
constexpr float EPS = 1e-6f;
constexpr float NEGBIG = -1e30f;

constexpr size_t MiB = 1u << 20;
constexpr size_t WS_MODV = 1 * MiB;
constexpr size_t WS_TABA = 1 * MiB + 128 * 1024;
constexpr size_t WS_TABD = 1 * MiB + 192 * 1024;
constexpr size_t WS_CS = 2 * MiB;
constexpr size_t WS_WINT = 8 * MiB;
constexpr size_t WS_WOUTT = 112 * MiB;
constexpr size_t WS_H = 144 * MiB;
constexpr size_t WS_PROJ = 208 * MiB;
constexpr size_t WS_VTA = 420 * MiB;
constexpr size_t WS_VTB = 426 * MiB;
constexpr size_t WS_VTD = 444 * MiB;
constexpr size_t WS_Y = 462 * MiB;
constexpr size_t WS_XR = 526 * MiB;
constexpr size_t WS_HO = 654 * MiB;
constexpr size_t WS_HL = 672 * MiB;
constexpr size_t WS_END = 674 * MiB;
static_assert(WS_PROJ + (size_t)SEQ * PP * 2 <= WS_VTA && WS_VTA + (size_t)64 * VTPP * 2 <= WS_VTB && WS_VTB + (size_t)256 * VTPP * 2 <= WS_VTD && WS_VTD + (size_t)256 * VTPP * 2 <= WS_Y, "d_ws map");
constexpr int TABA_N = 320, TABA_C = 160, TABD_N = 3073, TABD_C = 1536;

constexpr int NWAVES = 8;
constexpr int LDS_BYTES = 147456;

typedef float f32x2_c __attribute__((ext_vector_type(2))); typedef __bf16 bf16x2_c __attribute__((ext_vector_type(2)));
__device__ __forceinline__ unsigned cvt_pk_bf16(float lo, float hi) { f32x2_c v = {lo, hi}; bf16x2_c b = __builtin_convertvector(v, bf16x2_c); return __builtin_bit_cast(unsigned, b); }
__device__ __forceinline__ float bf_lo(unsigned u) { return __builtin_bit_cast(float, u << 16); }
__device__ __forceinline__ float bf_hi(unsigned u) { return __builtin_bit_cast(float, u & 0xffff0000u); }
__device__ __forceinline__ float silu_f(float z) { return z / (1.f + __expf(-z)); }
__device__ __forceinline__ float wave_sum(float v) {
#pragma unroll
    for (int o = 1; o < 64; o <<= 1) v += __shfl_xor(v, o);
    return v;
}

namespace pg8 {
constexpr int BM = 256, BK = 64, HALF = 128, HTB = HALF * BK * 2, STAGE_BYTES = 8 * HTB, NXCD = 8, WGM = 4;
__host__ __device__ __forceinline__ int lds_byte(int r, int c) { const int st = (r >> 4) * 2 + (c >> 5), rr = r & 15, cc = c & 31, ob = rr * 64 + cc * 2; return st * 1024 + (ob ^ (((ob >> 9) & 1) << 5)); }
__host__ __device__ __forceinline__ void stage_rc(int b, int& R, int& C) { const int st = b / 1024, sb = b % 1024, swz = sb ^ (((sb >> 9) & 1) << 5); R = (st >> 1) * 16 + swz / 64; C = (st & 1) * 32 + (swz % 64) / 2; }
__host__ __device__ __forceinline__ int perm32(int rho) { const int n = rho >> 4, i = rho & 15; return 8 * (i >> 2) + 4 * n + (i & 3); }

struct Unit { const char* a; const char* b; unsigned ldb2; int kind, pm, pn; };

template <class Epi, class Sched>
__device__ __forceinline__ void gemm_phase(const int tid, LAS unsigned char* lds, const int K, const Sched& S, const Epi& E) {
    const int wid = __builtin_amdgcn_readfirstlane(tid >> 6), lane = tid & 63, wr = wid >> 2, wc = wid & 3, fr = lane & 15, fq = lane >> 4;
    const int nt = K / BK;
    unsigned voffA[2], rB[2], cB2[2];
#pragma unroll
    for (int i = 0; i < 2; ++i) { int R, C; stage_rc(tid * 16 + i * 8192, R, C); const int Rb = (R & ~31) + perm32(R & 31);
        voffA[i] = (unsigned)(R * K + C) * 2u; rB[i] = (unsigned)Rb; cB2[i] = (unsigned)C * 2u; }
    const size_t kstep = (size_t)(BK * 2);
    const size_t hstepA = (size_t)HALF * K * 2;
    const unsigned ldsw = (unsigned)wid * 1024u;
    const int aoff = lds_byte(wr * 64 + fr, fq * 8), boff = lds_byte(wc * 32 + fr, fq * 8);
#define PG8_SA(b, h) (((b) * 2 + (h)) * HTB)
#define PG8_SB(b, h) ((4 + (b) * 2 + (h)) * HTB)
#define PG8_STAGE(bufoff, gbase, v0, v1) do { \
        __builtin_amdgcn_global_load_lds((const unsigned*)((const char*)(gbase) + (v0)), (LAS unsigned*)(lds + (bufoff) + ldsw), 16, 0, 0); \
        __builtin_amdgcn_global_load_lds((const unsigned*)((const char*)(gbase) + (v1)), (LAS unsigned*)(lds + (bufoff) + ldsw + 8192), 16, 0, 0); } while (0)
#define PG8_LDA(dst, b, h) do { _Pragma("unroll") for (int m = 0; m < 4; ++m) _Pragma("unroll") for (int k = 0; k < 2; ++k) dst[m][k] = *(const LAS bf16x8*)(lds + PG8_SA(b, h) + aoff + m * 2048 + k * 1024); } while (0)
#define PG8_LDB(dst, b, h) do { _Pragma("unroll") for (int n = 0; n < 2; ++n) _Pragma("unroll") for (int k = 0; k < 2; ++k) dst[n][k] = *(const LAS bf16x8*)(lds + PG8_SB(b, h) + boff + n * 2048 + k * 1024); } while (0)
#define PG8_MMA(ai, bj, At, Bt) do { __builtin_amdgcn_s_setprio(1); _Pragma("unroll") for (int m = 0; m < 4; ++m) _Pragma("unroll") for (int n = 0; n < 2; ++n) _Pragma("unroll") for (int k = 0; k < 2; ++k) \
        acc[ai][bj][m][n] = __builtin_amdgcn_mfma_f32_16x16x32_bf16(Bt[n][k], At[m][k], acc[ai][bj][m][n], 0, 0, 0); __builtin_amdgcn_s_setprio(0); } while (0)
#define PG8_WAIT_V(n) asm volatile("s_waitcnt vmcnt(" #n ")" ::: "memory")
#define PG8_WAIT_L(n) asm volatile("s_waitcnt lgkmcnt(" #n ")" ::: "memory")
#define PG8_BAR __builtin_amdgcn_s_barrier()
#define PG8_SCHED __builtin_amdgcn_sched_barrier(0)
    Unit cur, nxt; int ui = 0;
    if (!S.next(0, cur)) return;
    f32x4 acc[2][2][4][2];
#pragma unroll
    for (int a = 0; a < 2; ++a)
#pragma unroll
        for (int b = 0; b < 2; ++b)
#pragma unroll
            for (int m = 0; m < 4; ++m)
#pragma unroll
                for (int n = 0; n < 2; ++n) acc[a][b][m][n] = (f32x4){0.f, 0.f, 0.f, 0.f};
    bf16x8 At[4][2], B0[2][2], B1[2][2];
    const char* cA = cur.a; const char* cB = cur.b;
    unsigned vc0 = rB[0] * cur.ldb2 + cB2[0], vc1 = rB[1] * cur.ldb2 + cB2[1]; size_t hBc = (size_t)HALF * cur.ldb2;
    {
        PG8_STAGE(PG8_SB(0, 0), cB, vc0, vc1); PG8_STAGE(PG8_SB(0, 1), cB + hBc, vc0, vc1); PG8_STAGE(PG8_SA(0, 0), cA, voffA[0], voffA[1]); PG8_STAGE(PG8_SA(0, 1), cA + hstepA, voffA[0], voffA[1]);
        if (wr == 1) PG8_BAR;
        PG8_WAIT_V(2); PG8_BAR;
        PG8_STAGE(PG8_SB(1, 0), cB + kstep, vc0, vc1); PG8_STAGE(PG8_SA(1, 0), cA + kstep, voffA[0], voffA[1]); PG8_STAGE(PG8_SB(1, 1), cB + hBc + kstep, vc0, vc1);
        PG8_WAIT_V(6); PG8_BAR;
    }
    for (;;) {
        const bool has_next = S.next(ui + 1, nxt);
        const char* nA = has_next ? nxt.a : cA; const char* nB = has_next ? nxt.b : cB;
        const unsigned nldb = has_next ? nxt.ldb2 : cur.ldb2;
        const unsigned vn0 = rB[0] * nldb + cB2[0], vn1 = rB[1] * nldb + cB2[1]; const size_t hBn = (size_t)HALF * nldb;
        for (int t = 0; t < nt; t += 2) {
            const bool last = (t == nt - 2);
            const char* a1 = cA + (size_t)(t + 1) * kstep;
            const char* a2 = last ? nA : cA + (size_t)(t + 2) * kstep; const char* b2 = last ? nB : cB + (size_t)(t + 2) * kstep;
            const char* a3 = a2 + kstep; const char* b3 = b2 + kstep;
            const unsigned v20 = last ? vn0 : vc0, v21 = last ? vn1 : vc1; const size_t hB2 = last ? hBn : hBc;
            PG8_LDB(B0, 0, 0); PG8_LDB(B1, 0, 1); PG8_SCHED; PG8_LDA(At, 0, 0); PG8_STAGE(PG8_SA(1, 1), a1 + hstepA, voffA[0], voffA[1]);
            PG8_WAIT_V(8); PG8_WAIT_L(0); PG8_BAR; PG8_MMA(0, 0, At, B0); PG8_MMA(0, 1, At, B1); PG8_BAR; PG8_SCHED;
            PG8_LDA(At, 0, 1); PG8_STAGE(PG8_SB(0, 0), b2, v20, v21); PG8_STAGE(PG8_SB(0, 1), b2 + hB2, v20, v21); PG8_STAGE(PG8_SA(0, 0), a2, voffA[0], voffA[1]);
            PG8_WAIT_V(8); PG8_WAIT_L(0); PG8_BAR; PG8_MMA(1, 0, At, B0); PG8_MMA(1, 1, At, B1); PG8_BAR; PG8_SCHED;
            PG8_LDB(B0, 1, 0); PG8_LDB(B1, 1, 1); PG8_SCHED; PG8_LDA(At, 1, 0); PG8_STAGE(PG8_SA(0, 1), a2 + hstepA, voffA[0], voffA[1]);
            PG8_WAIT_V(8); PG8_WAIT_L(0); PG8_BAR; PG8_MMA(0, 0, At, B0); PG8_MMA(0, 1, At, B1); PG8_BAR; PG8_SCHED;
            PG8_LDA(At, 1, 1); PG8_STAGE(PG8_SB(1, 0), b3, v20, v21); PG8_STAGE(PG8_SB(1, 1), b3 + hB2, v20, v21); PG8_STAGE(PG8_SA(1, 0), a3, voffA[0], voffA[1]);
            PG8_WAIT_V(8); PG8_WAIT_L(0); PG8_BAR; PG8_MMA(1, 0, At, B0); PG8_MMA(1, 1, At, B1); PG8_BAR; PG8_SCHED;
        }
        if (wr == 0) PG8_BAR;
        E(acc, cur, wr, wc, fr, fq);
        if (!has_next) break;
#pragma unroll
        for (int a = 0; a < 2; ++a)
#pragma unroll
            for (int b = 0; b < 2; ++b)
#pragma unroll
                for (int m = 0; m < 4; ++m)
#pragma unroll
                    for (int n = 0; n < 2; ++n) acc[a][b][m][n] = (f32x4){0.f, 0.f, 0.f, 0.f};
        cur = nxt; cA = nA; cB = nB; vc0 = vn0; vc1 = vn1; hBc = hBn; ++ui;
        if (wr == 1) PG8_BAR;
    }
    PG8_WAIT_V(0);
    PG8_BAR;
#undef PG8_SA
#undef PG8_SB
#undef PG8_STAGE
#undef PG8_LDA
#undef PG8_LDB
#undef PG8_MMA
#undef PG8_WAIT_V
#undef PG8_WAIT_L
#undef PG8_BAR
#undef PG8_SCHED
}

__device__ __forceinline__ void grouped(int wgid, int nM, int nN, int& pm, int& pn) {
    const int nwg = nM * nN; { const int q = nwg / NXCD, r = nwg % NXCD, xcd = wgid % NXCD, off = wgid / NXCD; wgid = (xcd < r ? xcd * (q + 1) : r * (q + 1) + (xcd - r) * q) + off; }
    const int nig = WGM * nN, gid = wgid / nig, fm = gid * WGM, gsz = (nM - fm) < WGM ? (nM - fm) : WGM;
    pm = fm + ((wgid % nig) % gsz); pn = (wgid % nig) / gsz;
}

struct SchedIn {
    const char* H; const char* W; int G, c;
    __device__ __forceinline__ bool next(int i, Unit& u) const {
        const int Lx = i * G + c; if (Lx >= 1728) return false;
        if (Lx < 1408) { int pm, pi; grouped(Lx, 64, 22, pm, pi); const int pn = pi + (pi >= 9 ? 2 : 0) + (pi >= 20 ? 2 : 0);
            u.a = H + (size_t)pm * 256 * DMODEL * 2; u.b = W + (size_t)pn * 256 * DMODEL * 2; u.ldb2 = DMODEL * 2; u.kind = 0; u.pm = pm; u.pn = pn; }
        else { const int l2 = Lx - 1408, ft = l2 >> 6, tt = l2 & 63; const int pmf = ft == 0 ? 2 : (ft == 1 ? 9 : (ft == 2 ? 10 : (ft == 3 ? 22 : 23)));
            u.a = W + (size_t)pmf * 256 * DMODEL * 2;
            if (ft < 3) { u.b = H + (size_t)tt * 256 * DMODEL * 2; u.ldb2 = DMODEL * 2; }
            else { u.b = H + (size_t)(16 * 256 * (tt & 3) + (tt >> 2)) * DMODEL * 2; u.ldb2 = 16 * DMODEL * 2; }
            u.kind = 1; u.pm = ft; u.pn = tt; }
        return true;
    }
};
struct SchedOut {
    const char* Y; const char* W; int G, c;
    __device__ __forceinline__ bool next(int i, Unit& u) const {
        const int Lx = i * G + c; if (Lx >= 512) return false;
        int pm, pn; grouped(Lx, 64, 8, pm, pn);
        u.a = Y + (size_t)pm * 256 * DMODEL * 2; u.b = W + (size_t)pn * 256 * DMODEL * 2; u.ldb2 = DMODEL * 2; u.kind = 0; u.pm = pm; u.pn = pn; return true;
    }
};

struct EpiIn {
    bf16_t* PROJ; bf16_t* VTA; bf16_t* VTB; bf16_t* VTD; const float* CS; const float* qnw; const float* knw;
    __device__ __forceinline__ void operator()(const f32x4 (&acc)[2][2][4][2], const Unit& u, int wr, int wc, int fr, int fq) const {
        asm volatile("" : "+v"(fr), "+v"(fq));
        if (u.kind == 1) {
            const int ft = u.pm, tt = u.pn; bf16_t* base; int fbase, ai_lo = 0;
            if (ft == 0) { base = VTA; fbase = -128; ai_lo = 1; } else if (ft < 3) { base = VTB; fbase = (ft - 1) * 256; } else { base = VTD; fbase = (ft - 3) * 256; }
            for (int ai = ai_lo; ai < 2; ++ai)
#pragma unroll
                for (int m = 0; m < 4; ++m) { bf16_t* rowp = base + vt_off(fbase + 128 * ai + 64 * wr + 16 * m + fr, 256 * tt + 32 * wc + 8 * fq);
#pragma unroll
                    for (int bj = 0; bj < 2; ++bj) { const f32x4 v0 = ai ? acc[1][bj][m][0] : acc[0][bj][m][0], v1 = ai ? acc[1][bj][m][1] : acc[0][bj][m][1];
                        u32x4 w; w.x = cvt_pk_bf16(v0[0], v0[1]); w.y = cvt_pk_bf16(v0[2], v0[3]); w.z = cvt_pk_bf16(v1[0], v1[1]); w.w = cvt_pk_bf16(v1[2], v1[3]);
                        *(u32x4*)(rowp + bj * 256) = w; } }
            return;
        }
        const int pn = u.pn; const int row0 = u.pm * BM + wr * 64 + fr;
        if (pn >= 13 && pn <= 15) {
            const bool nrm = (pn < 15) || (wc < 2); const float* nw = (pn < 15) ? qnw : knw; const float sc = (pn < 15) ? C2 : 1.f;
            f32x4 wv[2][2];
#pragma unroll
            for (int bj = 0; bj < 2; ++bj)
#pragma unroll
                for (int n = 0; n < 2; ++n) wv[bj][n] = *(const f32x4*)(nw + 32 * bj + 8 * fq + 4 * n);
#pragma unroll
            for (int ai = 0; ai < 2; ++ai)
#pragma unroll
                for (int m = 0; m < 4; ++m) { const int row = row0 + ai * HALF + m * 16; bf16_t* rowp = PROJ + (size_t)row * PP + pn * 256 + 64 * wc + 8 * fq;
                    f32x4 v[2][2];
#pragma unroll
                    for (int bj = 0; bj < 2; ++bj)
#pragma unroll
                        for (int n = 0; n < 2; ++n) v[bj][n] = acc[ai][bj][m][n];
                    if (nrm) {
                        float ss = 0.f;
#pragma unroll
                        for (int bj = 0; bj < 2; ++bj)
#pragma unroll
                            for (int n = 0; n < 2; ++n) ss += v[bj][n][0] * v[bj][n][0] + v[bj][n][1] * v[bj][n][1] + v[bj][n][2] * v[bj][n][2] + v[bj][n][3] * v[bj][n][3];
                        ss += __shfl_xor(ss, 16); ss += __shfl_xor(ss, 32);
                        const float rinv = __builtin_amdgcn_rsqf(ss * (1.f / 64.f) + EPS);
#pragma unroll
                        for (int bj = 0; bj < 2; ++bj)
#pragma unroll
                            for (int n = 0; n < 2; ++n) { const f32x4 x = v[bj][n] * wv[bj][n] * rinv; const f32x4 cs = *(const f32x4*)(CS + ((size_t)row * 32 + 16 * bj + 4 * fq + 2 * n) * 2);
                                f32x4 o; o[0] = x[0] * cs[0] - x[1] * cs[1]; o[1] = x[0] * cs[1] + x[1] * cs[0]; o[2] = x[2] * cs[2] - x[3] * cs[3]; o[3] = x[2] * cs[3] + x[3] * cs[2]; v[bj][n] = o * sc; }
                    }
#pragma unroll
                    for (int bj = 0; bj < 2; ++bj) { u32x4 w; w.x = cvt_pk_bf16(v[bj][0][0], v[bj][0][1]); w.y = cvt_pk_bf16(v[bj][0][2], v[bj][0][3]); w.z = cvt_pk_bf16(v[bj][1][0], v[bj][1][1]); w.w = cvt_pk_bf16(v[bj][1][2], v[bj][1][3]);
                        *(u32x4*)(rowp + 32 * bj) = w; } }
            return;
        }
        const float sc = (pn == 0 || pn == 1 || pn == 5 || pn == 6 || pn == 18 || pn == 19) ? C2 : 1.f;
        const int col0 = pn * BM + wc * 32 + 8 * fq;
#pragma unroll
        for (int ai = 0; ai < 2; ++ai)
#pragma unroll
            for (int m = 0; m < 4; ++m) { bf16_t* rowp = PROJ + (size_t)(row0 + ai * HALF + m * 16) * PP + col0;
#pragma unroll
                for (int bj = 0; bj < 2; ++bj) { const f32x4 v0 = acc[ai][bj][m][0] * sc, v1 = acc[ai][bj][m][1] * sc;
                    u32x4 w; w.x = cvt_pk_bf16(v0[0], v0[1]); w.y = cvt_pk_bf16(v0[2], v0[3]); w.z = cvt_pk_bf16(v1[0], v1[1]); w.w = cvt_pk_bf16(v1[2], v1[3]);
                    *(u32x4*)(rowp + bj * HALF) = w; } }
    }
};

struct EpiOut {
    const float* xin; float* xout; const float* gate;
    __device__ __forceinline__ void operator()(const f32x4 (&acc)[2][2][4][2], const Unit& u, int wr, int wc, int fr, int fq) const {
        asm volatile("" : "+v"(fr), "+v"(fq));
        const int row0 = u.pm * BM + wr * 64 + fr, col0 = u.pn * BM + wc * 32 + 8 * fq;
        f32x4 g[2][2];
#pragma unroll
        for (int bj = 0; bj < 2; ++bj)
#pragma unroll
            for (int n = 0; n < 2; ++n) g[bj][n] = *(const f32x4*)(gate + col0 + bj * HALF + 4 * n);
#pragma unroll
        for (int ai = 0; ai < 2; ++ai)
#pragma unroll
            for (int m = 0; m < 4; ++m) { const size_t ro = (size_t)(row0 + ai * HALF + m * 16) * DMODEL + col0;
#pragma unroll
                for (int bj = 0; bj < 2; ++bj)
#pragma unroll
                    for (int n = 0; n < 2; ++n) { const f32x4 x = *(const f32x4*)(xin + ro + bj * HALF + 4 * n); *(f32x4*)(xout + ro + bj * HALF + 4 * n) = x + g[bj][n] * acc[ai][bj][m][n]; } }
    }
};
}

namespace attn_body {
using bf16 = __hip_bfloat16;
using s16x4 = __attribute__((ext_vector_type(4))) short;
constexpr int D = 64, NW = 8, QBLK = 32, QB = QBLK * NW, KVBLK = 64;
__device__ __forceinline__ int crow(int r, int hi) { return (r & 3) + 8 * (r >> 2) + 4 * hi; }
#define SBAR() __builtin_amdgcn_sched_barrier(0)
constexpr int NSLOT = 3, SLOTB = 8192;
constexpr int LDS_K = 0, LDS_V = NSLOT * SLOTB, LDS_WS = 2 * NSLOT * SLOTB, LDS_OST = LDS_WS + NW * 64 * 4, LDS_BYTES = LDS_OST + NW * 4096;
__device__ __forceinline__ void glds16(const void* gsrc, unsigned lds_dst) { unsigned keep;
  asm volatile("s_mov_b32 %0, m0\n\ts_mov_b32 m0, %2\n\ts_nop 0\n\tglobal_load_lds_dwordx4 %1, off\n\ts_mov_b32 m0, %0" : "=&s"(keep) : "v"(gsrc), "s"(lds_dst) : "memory"); }
__device__ __forceinline__ float max3f(float a, float b, float c) { float r; asm("v_max3_f32 %0, %1, %2, %3" : "=v"(r) : "v"(a), "v"(b), "v"(c)); return r; }
__device__ __forceinline__ float max2f(float a, float b) { float r; asm("v_max_f32_e32 %0, %1, %2" : "=v"(r) : "v"(a), "v"(b)); return r; }
__device__ __forceinline__ float fadd_s(float a, float b) { float r; asm("v_add_f32_e32 %0, %1, %2" : "=v"(r) : "v"(a), "v"(b)); return r; }
__device__ __forceinline__ float fsub_s(float a, float b) { float r; asm("v_sub_f32_e32 %0, %1, %2" : "=v"(r) : "v"(a), "v"(b)); return r; }
typedef float f32x2_t __attribute__((ext_vector_type(2))); typedef __bf16 bf16x2_t __attribute__((ext_vector_type(2)));
__device__ __forceinline__ unsigned cvtpk_s(float lo, float hi) { f32x2_t v = {lo, hi}; bf16x2_t b = __builtin_convertvector(v, bf16x2_t); return __builtin_bit_cast(unsigned, b); }
#define WAIT_BAR(N) asm volatile("s_waitcnt vmcnt(" #N ") lgkmcnt(0)\n\ts_barrier" ::: "memory")
__device__ __forceinline__ void qkt(f32x16& p0, f32x16& p1, const char* Kslot, const bf16x8* qr, const f32x16& negm, int r32, int hi) {
  const char* kb = Kslot + hi * 1024 + r32 * 16;
  #pragma unroll
  for (int d0 = 0; d0 < 4; ++d0) {
    const bf16x8 b0 = *reinterpret_cast<const bf16x8*>(kb + d0 * 2048);
    const bf16x8 b1 = *reinterpret_cast<const bf16x8*>(kb + d0 * 2048 + 512);
    if (d0 == 0) { p0 = __builtin_amdgcn_mfma_f32_32x32x16_bf16(b0, qr[0], negm, 0, 0, 0); p1 = __builtin_amdgcn_mfma_f32_32x32x16_bf16(b1, qr[0], negm, 0, 0, 0); }
    else { p0 = __builtin_amdgcn_mfma_f32_32x32x16_bf16(b0, qr[d0], p0, 0, 0, 0); p1 = __builtin_amdgcn_mfma_f32_32x32x16_bf16(b1, qr[d0], p1, 0, 0, 0); } }
}
typedef __attribute__((address_space(3))) const char* lds_cptr;
typedef short v4i16_t __attribute__((ext_vector_type(4)));
__device__ __forceinline__ void kload8(bf16x8* kf, lds_cptr kp) {
  kf[0] = *(const LAS bf16x8*)(kp);        kf[1] = *(const LAS bf16x8*)(kp + 512);
  kf[2] = *(const LAS bf16x8*)(kp + 2048); kf[3] = *(const LAS bf16x8*)(kp + 2560);
  kf[4] = *(const LAS bf16x8*)(kp + 4096); kf[5] = *(const LAS bf16x8*)(kp + 4608);
  kf[6] = *(const LAS bf16x8*)(kp + 6144); kf[7] = *(const LAS bf16x8*)(kp + 6656);
}
__device__ __forceinline__ void kload2(bf16x8* kf, lds_cptr kp, int j) { kf[2 * j] = *(const LAS bf16x8*)(kp + j * 2048); kf[2 * j + 1] = *(const LAS bf16x8*)(kp + j * 2048 + 512); }
__device__ __forceinline__ s16x4 vtr(lds_cptr p) { return __builtin_bit_cast(s16x4, __builtin_amdgcn_ds_read_tr16_b64_v4i16((LAS v4i16_t*)p)); }
__device__ __forceinline__ float rowmax(const f32x16& p0, const f32x16& p1) {
  float a = max3f(p0[0], p0[1], p1[0]), b = max3f(p0[2], p0[3], p1[1]); a = max3f(a, p1[2], p1[3]);
  #pragma unroll
  for (int r = 4; r < 16; r += 4) { a = max3f(a, p0[r], p0[r + 1]); b = max3f(b, p0[r + 2], p0[r + 3]); a = max3f(a, p1[r], p1[r + 1]); b = max3f(b, p1[r + 2], p1[r + 3]); }
  const float m = max2f(a, b);
  auto rr = __builtin_amdgcn_permlane32_swap(__float_as_uint(m), __float_as_uint(m), false, false);
  return max2f(__uint_as_float(rr[0]), __uint_as_float(rr[1]));
}
__device__ __forceinline__ void pv(f32x16* o, int vb, bf16x8 pa0, bf16x8 pa1, bf16x8 pa2, bf16x8 pa3) {
  #pragma unroll
  for (int d0 = 0; d0 < 2; ++d0) { s16x4 lo[4], hi[4];
    #pragma unroll
    for (int ks = 0; ks < 4; ++ks) {
      asm volatile("ds_read_b64_tr_b16 %0,%1 offset:%c2" : "=&v"(lo[ks]) : "v"(vb), "i"(d0 * 4096 + ks * 1024) : "memory");
      asm volatile("ds_read_b64_tr_b16 %0,%1 offset:%c2" : "=&v"(hi[ks]) : "v"(vb), "i"(d0 * 4096 + ks * 1024 + 512) : "memory"); }
    asm volatile("s_waitcnt lgkmcnt(0)" ::: "memory"); SBAR();
    #define PK(k) (bf16x8){lo[k][0], lo[k][1], lo[k][2], lo[k][3], hi[k][0], hi[k][1], hi[k][2], hi[k][3]}
    o[d0] = __builtin_amdgcn_mfma_f32_32x32x16_bf16(pa0, PK(0), o[d0], 0, 0, 0);
    o[d0] = __builtin_amdgcn_mfma_f32_32x32x16_bf16(pa1, PK(1), o[d0], 0, 0, 0);
    o[d0] = __builtin_amdgcn_mfma_f32_32x32x16_bf16(pa2, PK(2), o[d0], 0, 0, 0);
    o[d0] = __builtin_amdgcn_mfma_f32_32x32x16_bf16(pa3, PK(3), o[d0], 0, 0, 0);
    #undef PK
  }
}

template <int THRL> __device__ __forceinline__ void attn_unit(const int tid, const float mfix, int q0, int NT, const bf16* Qh, const bf16* __restrict__ Kh, const bf16* __restrict__ Vh, const bf16* Zh, bf16* Oh, const long PQ, const long PO, char* shm) {
  const int lane = tid & 63, r32 = lane & 31, hi = lane >> 5; const int wid = __builtin_amdgcn_readfirstlane(tid >> 6);
  const bf16* Qw = Qh + (long)(q0 + wid * QBLK) * PQ;
  const unsigned lds0 = (unsigned)(uintptr_t)shm;
  float* wsf = (float*)(shm + LDS_WS) + wid * 64;
  const bf16* ksrc = Kh + (long)lane * PQ + wid * 8;
  const bf16* vsrc = Vh + (long)(16 * (wid & 3) + (lane >> 2)) * PQ + (wid >> 2) * 32 + (lane & 3) * 8;
  const unsigned kdst = lds0 + LDS_K + wid * 1024, vdst = lds0 + LDS_V + wid * 1024;
  #define DMA_K(t, slot) glds16(ksrc + (long)(t) * KVBLK * PQ, (unsigned)__builtin_amdgcn_readfirstlane(kdst + (slot)))
  #define DMA_V(t, slot) glds16(vsrc + (long)(t) * KVBLK * PQ, (unsigned)__builtin_amdgcn_readfirstlane(vdst + (slot)))
  const int vb0 = (int)(lds0 + LDS_V) + ((lane >> 4) & 1) * 32 + (lane & 3) * 8 + (4 * hi + ((lane & 15) >> 2)) * 64;
  const char* Kbase = shm + LDS_K; bf16x8 kf[8];
  const lds_cptr shm3 = (lds_cptr)shm; const lds_cptr kp0 = shm3 + LDS_K + hi * 1024 + r32 * 16; const lds_cptr vp0 = shm3 + LDS_V + ((lane >> 4) & 1) * 32 + (lane & 3) * 8 + (4 * hi + ((lane & 15) >> 2)) * 64;
  DMA_K(0, 0); DMA_V(0, 0); DMA_K(1, SLOTB);
  bf16x8 qr[4];
  #pragma unroll
  for (int d0 = 0; d0 < 4; ++d0) qr[d0] = *reinterpret_cast<const bf16x8*>(&Qw[(long)r32 * PQ + d0 * 16 + hi * 8]);
  float zf_; asm volatile("v_mov_b32 %0, 0" : "=v"(zf_)); f32x16 zv_;
  #pragma unroll
  for (int r = 0; r < 16; ++r) zv_[r] = zf_;
  float l_reg = 0.f; f32x16 o[2]; o[0] = zv_; o[1] = zv_; f32x16 negm;
  #pragma unroll
  for (int r = 0; r < 16; ++r) negm[r] = -mfix;
  asm volatile("" : "+v"(negm));
  #define START(P0, P1) do { _Pragma("unroll") for (int r = 0; r < 16; ++r) P0[r] = __builtin_amdgcn_exp2f(P0[r]); } while (0)
  #define RESC() do { } while (0)
  f32x16 pA0, pA1, pB0, pB1;
  int sl_prev = 0, sl_cur = 0, sl_next = SLOTB;
  #define ROT() do { sl_prev = sl_cur; sl_cur = sl_next; sl_next = (sl_next == (NSLOT - 1) * SLOTB) ? 0 : sl_next + SLOTB; } while (0)
  DMA_K(2, 2 * SLOTB);
  WAIT_BAR(3);
  qkt(pA0, pA1, Kbase, qr, negm, r32, hi); asm volatile("s_nop 15\n\ts_nop 7" : "+v"(pA0), "+v"(pA1));
  START(pA0, pA1);
  _Pragma("unroll") for (int r = 0; r < 16; ++r) pA1[r] = __builtin_amdgcn_exp2f(pA1[r]);
  WAIT_BAR(0);
  DMA_K(3, 0); DMA_V(1, SLOTB);
  ROT();
  kload8(kf, kp0 + sl_cur);
  WAIT_BAR(2);
  s16x4 vlo[8], vhi[8]; u32x4 pw0, pw1, pw2, pw3;
  #define PKW(P, B) cvtpk_s(P[B], P[B + 1])
  #define PAF(k) __builtin_bit_cast(bf16x8, pw##k)
  #define VFR(i) (bf16x8){vlo[i][0], vlo[i][1], vlo[i][2], vlo[i][3], vhi[i][0], vhi[i][1], vhi[i][2], vhi[i][3]}
  #define PIN(x) asm volatile("" : "+v"(x))
  #define MX3(a, b, c) __builtin_fmaxf(__builtin_fmaxf((a), (b)), (c))
  #define GAPA(MF, A0, A1, A2, A3, W0, W1, PW) do { MF; sacc += A0; sacc += A1; sacc += A2; sacc += A3; PIN(sacc); W0; W1; PIN(PW); SBAR(); } while (0)
  #define EX(v) __builtin_amdgcn_exp2f(v)
  #define GAPB(MF, X, B) do { MF; X[B] = EX(X[B]); X[B + 1] = EX(X[B + 1]); X[B + 2] = EX(X[B + 2]); X[B + 3] = EX(X[B + 3]); PIN(X); SBAR(); } while (0)
  #define VRD(i) do { vlo[i] = vtr(vp_ + (((i) >> 2) * 4096 + ((i) & 3) * 1024)); vhi[i] = vtr(vp_ + (((i) >> 2) * 4096 + ((i) & 3) * 1024 + 512)); } while (0)
  #define KRD(G, j) do { if (G) { kload2(kf, kp0 + sl_next, j); SBAR(); } } while (0)
  #define STEP(C0, C1, P0, P1, t, GK, GV, GL) do { SBAR(); \
    const lds_cptr vp_ = vp0 + sl_prev; \
    VRD(0); SBAR(); float sacc = (P0[0] + P0[1]); \
    GAPA(C0 = __builtin_amdgcn_mfma_f32_32x32x16_bf16(kf[0], qr[0], negm, 0, 0, 0), P0[2], P0[3], P0[4], P0[5],     pw0[0] = PKW(P0, 0), pw0[1] = PKW(P0, 2), pw0); \
    VRD(4); SBAR(); GAPA(C1 = __builtin_amdgcn_mfma_f32_32x32x16_bf16(kf[1], qr[0], negm, 0, 0, 0), P0[6], P0[7], P0[8], P0[9],     pw0[2] = PKW(P0, 4), pw0[3] = PKW(P0, 6), pw0); \
    VRD(1); SBAR(); GAPA(C0 = __builtin_amdgcn_mfma_f32_32x32x16_bf16(kf[2], qr[1], C0, 0, 0, 0),   P0[10], P0[11], P0[12], P0[13], pw1[0] = PKW(P0, 8), pw1[1] = PKW(P0, 10), pw1); \
    VRD(5); SBAR(); GAPA(C1 = __builtin_amdgcn_mfma_f32_32x32x16_bf16(kf[3], qr[1], C1, 0, 0, 0),   P0[14], P0[15], P1[0], P1[1],   pw1[2] = PKW(P0, 12), pw1[3] = PKW(P0, 14), pw1); \
    VRD(2); SBAR(); GAPA(C0 = __builtin_amdgcn_mfma_f32_32x32x16_bf16(kf[4], qr[2], C0, 0, 0, 0),   P1[2], P1[3], P1[4], P1[5],     pw2[0] = PKW(P1, 0), pw2[1] = PKW(P1, 2), pw2); \
    VRD(6); SBAR(); GAPA(C1 = __builtin_amdgcn_mfma_f32_32x32x16_bf16(kf[5], qr[2], C1, 0, 0, 0),   P1[6], P1[7], P1[8], P1[9],     pw2[2] = PKW(P1, 4), pw2[3] = PKW(P1, 6), pw2); \
    VRD(3); SBAR(); GAPA(C0 = __builtin_amdgcn_mfma_f32_32x32x16_bf16(kf[6], qr[3], C0, 0, 0, 0),   P1[10], P1[11], P1[12], P1[13], pw3[0] = PKW(P1, 8), pw3[1] = PKW(P1, 10), pw3); \
    VRD(7); SBAR(); GAPA(C1 = __builtin_amdgcn_mfma_f32_32x32x16_bf16(kf[7], qr[3], C1, 0, 0, 0),   P1[14], P1[15], 0.f, 0.f,       pw3[2] = PKW(P1, 12), pw3[3] = PKW(P1, 14), pw3); \
    l_reg += sacc; \
    if (GK) { DMA_K((t) + 3, sl_cur); } if (GV) { DMA_V((t) + 1, sl_next); } \
    SBAR(); \
    GAPB(o[0] = __builtin_amdgcn_mfma_f32_32x32x16_bf16(PAF(0), VFR(0), o[0], 0, 0, 0), C0, 0); \
    GAPB(o[1] = __builtin_amdgcn_mfma_f32_32x32x16_bf16(PAF(0), VFR(4), o[1], 0, 0, 0), C0, 4); \
    KRD(GL, 0); GAPB(o[0] = __builtin_amdgcn_mfma_f32_32x32x16_bf16(PAF(1), VFR(1), o[0], 0, 0, 0), C0, 8); \
    KRD(GL, 1); GAPB(o[1] = __builtin_amdgcn_mfma_f32_32x32x16_bf16(PAF(1), VFR(5), o[1], 0, 0, 0), C0, 12); \
    KRD(GL, 2); GAPB(o[0] = __builtin_amdgcn_mfma_f32_32x32x16_bf16(PAF(2), VFR(2), o[0], 0, 0, 0), C1, 0); \
    KRD(GL, 3); GAPB(o[1] = __builtin_amdgcn_mfma_f32_32x32x16_bf16(PAF(2), VFR(6), o[1], 0, 0, 0), C1, 4); \
    GAPB(o[0] = __builtin_amdgcn_mfma_f32_32x32x16_bf16(PAF(3), VFR(3), o[0], 0, 0, 0), C1, 8); \
    GAPB(o[1] = __builtin_amdgcn_mfma_f32_32x32x16_bf16(PAF(3), VFR(7), o[1], 0, 0, 0), C1, 12); \
    } while (0)
  int t = 1;
  for (; t + 5 < NT; t += 2) {
    STEP(pB0, pB1, pA0, pA1, t, true, true, true);     WAIT_BAR(2); RESC(); ROT();
    STEP(pA0, pA1, pB0, pB1, t + 1, true, true, true); WAIT_BAR(2); RESC(); ROT();
  }
  #define ENDW(tt) do { if ((tt) + 3 < NT) { WAIT_BAR(2); } else if ((tt) + 2 < NT) { WAIT_BAR(1); } else { WAIT_BAR(0); } } while (0)
  for (; t + 1 < NT; t += 2) {
    STEP(pB0, pB1, pA0, pA1, t, (t + 3 < NT), (t + 1 < NT), (t + 1 < NT));         ENDW(t);     RESC(); ROT();
    STEP(pA0, pA1, pB0, pB1, t + 1, (t + 4 < NT), (t + 2 < NT), (t + 2 < NT));     ENDW(t + 1); RESC(); ROT();
  }
  STEP(pB0, pB1, pA0, pA1, NT - 1, false, false, false); RESC();
  { float sacc = pB0[0] + pB0[1]; _Pragma("unroll") for (int r = 2; r < 16; ++r) sacc += pB0[r]; _Pragma("unroll") for (int r = 0; r < 16; ++r) sacc += pB1[r]; l_reg += sacc;
    pw0 = (u32x4){PKW(pB0, 0), PKW(pB0, 2), PKW(pB0, 4), PKW(pB0, 6)}; pw1 = (u32x4){PKW(pB0, 8), PKW(pB0, 10), PKW(pB0, 12), PKW(pB0, 14)}; pw2 = (u32x4){PKW(pB1, 0), PKW(pB1, 2), PKW(pB1, 4), PKW(pB1, 6)}; pw3 = (u32x4){PKW(pB1, 8), PKW(pB1, 10), PKW(pB1, 12), PKW(pB1, 14)};
    SBAR(); pv(o, vb0 + sl_cur, PAF(0), PAF(1), PAF(2), PAF(3)); }
  #undef PKW
  #undef PAF
  #undef VFR
  #undef PIN
  #undef MX3
  #undef GAPA
  #undef GAPB
  #undef EX
  #undef VRD
  #undef KRD
  #undef STEP
  #undef ENDW
  { auto rr = __builtin_amdgcn_permlane32_swap(__float_as_uint(l_reg), __float_as_uint(l_reg), false, false); l_reg = __uint_as_float(rr[0]) + __uint_as_float(rr[1]); }
  if (hi == 0) wsf[32 + r32] = l_reg; asm volatile("s_waitcnt lgkmcnt(0)" ::: "memory");
  float rli[16];
  #pragma unroll
  for (int r = 0; r < 16; ++r) rli[r] = __builtin_amdgcn_rcpf(wsf[32 + crow(r, hi)]);
  bf16* Ow = Oh + (long)(q0 + wid * QBLK) * PO;
  const bf16* Zw = Zh + (long)(q0 + wid * QBLK) * PQ;
  { bf16* stg = (bf16*)(shm + LDS_OST) + wid * 2048;
    #pragma unroll
    for (int r = 0; r < 16; ++r) { const int orow = crow(r, hi);
      #pragma unroll
      for (int d0 = 0; d0 < 2; ++d0) stg[orow * 64 + d0 * 32 + r32] = __float2bfloat16(o[d0][r] * rli[r]); }
    asm volatile("s_waitcnt lgkmcnt(0)" ::: "memory");
    #pragma unroll
    for (int i = 0; i < 4; ++i) { const int row = i * 8 + (lane >> 3), ch = lane & 7; const u32x4 v = *(const u32x4*)(stg + row * 64 + ch * 8);
      const u32x4 z = *(const u32x4*)(Zw + (long)row * PQ + ch * 8); u32x4 w;
      #pragma unroll
      for (int e = 0; e < 4; ++e) w[e] = cvt_pk_bf16(bf_lo(v[e]) * silu_f(bf_lo(z[e])), bf_hi(v[e]) * silu_f(bf_hi(z[e])));
      *(u32x4*)(Ow + (long)row * PO + ch * 8) = w; } }
  asm volatile("s_waitcnt lgkmcnt(0)\n\ts_barrier" ::: "memory");
  #undef DMA_K
  #undef DMA_V
  #undef START
  #undef RESC
  #undef ROT
}
#undef WAIT_BAR
}

struct LA { f32x16 o0, o1; float m, l; };
__device__ __forceinline__ f32x16 zero16() { float z; asm volatile("v_mov_b32 %0, 0" : "=v"(z)); f32x16 v;
#pragma unroll
    for (int r = 0; r < 16; ++r) v[r] = z;
    return v; }
struct Frag { bf16x8 k[4], v[4]; };
struct TP { unsigned koff, voff; const LAS char* tp; int cb; const LAS char* tp2; };
__device__ __forceinline__ void la_loadK(Frag& f, const char* kb, const TP& t) {
#pragma unroll
    for (int d0 = 0; d0 < 4; ++d0) f.k[d0] = *(const bf16x8*)(kb + t.koff + d0 * 32);
}
struct VSG { const char* b;
    template <int V1> __device__ __forceinline__ void load(Frag& f, unsigned voff) const { const char* p = b + (long)(int)voff; const char* q = p + (size_t)16 * VTPP * 2;
        f.v[0] = *(const bf16x8*)(p); f.v[1] = *(const bf16x8*)(p + V1); f.v[2] = *(const bf16x8*)(q); f.v[3] = *(const bf16x8*)(q + V1); } };
constexpr int VSL_PITCH = 1296;
struct VSL { const LAS char* b;
    template <int V1> __device__ __forceinline__ void load(Frag& f, unsigned voff) const { const LAS char* p = b + voff; const LAS char* q = p + 32 * VSL_PITCH;
        f.v[0] = *(const LAS bf16x8*)(p); f.v[1] = *(const LAS bf16x8*)(p + V1); f.v[2] = *(const LAS bf16x8*)(q); f.v[3] = *(const LAS bf16x8*)(q + V1); } };
template <int TS4, int TG4> struct MBTab {
    __device__ __forceinline__ static float apply(const TP& t, int reg, float s) { return s + *(const LAS float*)(t.tp + (reg & 7) * TS4 + (reg >> 3) * TG4); }
    __device__ __forceinline__ static TP second(const TP& t) { TP b = t; b.tp = t.tp2; return b; }
};
template <int GI4, int GC> struct MBNa {
    __device__ __forceinline__ static float apply(const TP& t, int reg, float s) { const float b = *(const LAS float*)(t.tp + (reg & 7) * 4 + (reg >> 3) * GI4);
        return (unsigned)(t.cb + (reg & 7) + (reg >> 3) * GC) < 16u ? s + b : NEGBIG; }
    __device__ __forceinline__ static TP second(const TP& t) { TP b = t; b.tp = t.tp2; return b; }
};
template <int GI4> struct MBNaXM {
    __device__ __forceinline__ static float apply(const TP& t, int reg, float s) { const float b = *(const LAS float*)(t.tp + (reg & 7) * 4 + (reg >> 3) * GI4);
        const bool col = (unsigned)((int)(short)(t.cb & 0xffff) + (reg & 7)) < 16u, row = (t.cb >> (reg < 8 ? 16 : 17)) & 1; return (col && row) ? s + b : NEGBIG; }
    __device__ __forceinline__ static TP second(const TP& t) { TP b = t; b.tp = t.tp2; b.cb = (t.cb & 0xffff) | ((t.cb >> 4) & 0x30000); return b; }
};
template <class MB, int V1, class VS> __device__ __forceinline__ void la_step(LA& st, const bf16x8 (&qf)[4], Frag& f, const char* kb, const VS& vs, const TP& t, const TP& n) {
    f32x16 s = zero16();
#pragma unroll
    for (int d0 = 0; d0 < 4; ++d0) s = __builtin_amdgcn_mfma_f32_32x32x16_bf16(f.k[d0], qf[d0], s, 0, 0, 0);
    la_loadK(f, kb, n);
    float mx = NEGBIG;
#pragma unroll
    for (int r = 0; r < 16; ++r) { s[r] = MB::apply(t, r, s[r]); mx = __builtin_fmaxf(mx, s[r]); }
    { auto rr = __builtin_amdgcn_permlane32_swap(__float_as_uint(mx), __float_as_uint(mx), false, false); mx = __builtin_fmaxf(__uint_as_float(rr[0]), __uint_as_float(rr[1])); }
    if (__any(mx > st.m)) { const float mn = __builtin_fmaxf(st.m, mx), alpha = __builtin_amdgcn_exp2f(st.m - mn); st.m = mn; st.l *= alpha; st.o0 *= alpha; st.o1 *= alpha; }
    float rs = 0.f;
#pragma unroll
    for (int r = 0; r < 16; ++r) { s[r] = __builtin_amdgcn_exp2f(s[r] - st.m); rs += s[r]; }
    st.l += rs;
    u32x4 p0, p1;
#pragma unroll
    for (int e = 0; e < 4; ++e) { p0[e] = cvt_pk_bf16(s[2 * e], s[2 * e + 1]); p1[e] = cvt_pk_bf16(s[8 + 2 * e], s[8 + 2 * e + 1]); }
    const bf16x8 pf0 = __builtin_bit_cast(bf16x8, p0), pf1 = __builtin_bit_cast(bf16x8, p1);
    st.o0 = __builtin_amdgcn_mfma_f32_32x32x16_bf16(f.v[0], pf0, st.o0, 0, 0, 0); st.o0 = __builtin_amdgcn_mfma_f32_32x32x16_bf16(f.v[1], pf1, st.o0, 0, 0, 0);
    st.o1 = __builtin_amdgcn_mfma_f32_32x32x16_bf16(f.v[2], pf0, st.o1, 0, 0, 0); st.o1 = __builtin_amdgcn_mfma_f32_32x32x16_bf16(f.v[3], pf1, st.o1, 0, 0, 0);
    vs.template load<V1>(f, n.voff);
}
template <int TS4, int TG4> struct MBTabM {
    __device__ __forceinline__ static float apply(const TP& t, int reg, float s) { const float v = s + *(const LAS float*)(t.tp + (reg & 7) * TS4 + (reg >> 3) * TG4);
        return (t.cb & (reg < 8 ? 1 : 2)) ? NEGBIG : v; }
    __device__ __forceinline__ static TP second(const TP& t) { TP b = t; b.tp = t.tp2; return b; }
};
typedef MBTabM<64, 1024> MB_D4M;
typedef MBTab<64, 8> MB_D1; typedef MBTab<4, 64> MB_A; typedef MBNa<64, 16> MB_B; typedef MBNa<1024, 0> MB_BX; typedef MBNaXM<1024> MB_BXM; typedef MBTab<64, 1024> MB_D16; typedef MBTab<64, 32> MB_D4;
#define LA_RUN(NT, TILE, MB, V1, KB, VS_) do { Frag f_; { const TP t0_ = TILE(0); la_loadK(f_, KB, t0_); (VS_).template load<V1>(f_, t0_.voff); } \
    _Pragma("unroll 1") for (int i_ = 0; i_ < (NT); ++i_) { const TP t_ = TILE(i_); const TP n_ = TILE(i_ + 1 < (NT) ? i_ + 1 : i_); la_step<MB, V1>(st, qf, f_, KB, VS_, t_, n_); } } while (0)
template <class MB> __device__ __forceinline__ void la_soft(LA& st, f32x16& s, const TP& t, bf16x8& pf0, bf16x8& pf1) {
    float mx = NEGBIG;
#pragma unroll
    for (int r = 0; r < 16; ++r) { s[r] = MB::apply(t, r, s[r]); mx = __builtin_fmaxf(mx, s[r]); }
    { auto rr = __builtin_amdgcn_permlane32_swap(__float_as_uint(mx), __float_as_uint(mx), false, false); mx = __builtin_fmaxf(__uint_as_float(rr[0]), __uint_as_float(rr[1])); }
    if (__any(mx > st.m)) { const float mn = __builtin_fmaxf(st.m, mx), alpha = __builtin_amdgcn_exp2f(st.m - mn); st.m = mn; st.l *= alpha; st.o0 *= alpha; st.o1 *= alpha; }
    float rs = 0.f;
#pragma unroll
    for (int r = 0; r < 16; ++r) { s[r] = __builtin_amdgcn_exp2f(s[r] - st.m); rs += s[r]; }
    st.l += rs;
    u32x4 p0, p1;
#pragma unroll
    for (int e = 0; e < 4; ++e) { p0[e] = cvt_pk_bf16(s[2 * e], s[2 * e + 1]); p1[e] = cvt_pk_bf16(s[8 + 2 * e], s[8 + 2 * e + 1]); }
    pf0 = __builtin_bit_cast(bf16x8, p0); pf1 = __builtin_bit_cast(bf16x8, p1);
}
template <class MB, int V1, class VS> __device__ __forceinline__ void la_step2(LA& sa, LA& sb, const bf16x8 (&qa)[4], const bf16x8 (&qb)[4], Frag& f, const char* kb, const VS& vs, const TP& t, const TP& n) {
    bf16x8 pa0, pa1;
    { f32x16 s0 = zero16();
#pragma unroll
      for (int d0 = 0; d0 < 4; ++d0) s0 = __builtin_amdgcn_mfma_f32_32x32x16_bf16(f.k[d0], qa[d0], s0, 0, 0, 0);
      la_soft<MB>(sa, s0, t, pa0, pa1); }
    f32x16 s1 = zero16();
#pragma unroll
    for (int d0 = 0; d0 < 4; ++d0) s1 = __builtin_amdgcn_mfma_f32_32x32x16_bf16(f.k[d0], qb[d0], s1, 0, 0, 0);
    la_loadK(f, kb, n);
    sa.o0 = __builtin_amdgcn_mfma_f32_32x32x16_bf16(f.v[0], pa0, sa.o0, 0, 0, 0); sa.o1 = __builtin_amdgcn_mfma_f32_32x32x16_bf16(f.v[2], pa0, sa.o1, 0, 0, 0);
    sa.o0 = __builtin_amdgcn_mfma_f32_32x32x16_bf16(f.v[1], pa1, sa.o0, 0, 0, 0); sa.o1 = __builtin_amdgcn_mfma_f32_32x32x16_bf16(f.v[3], pa1, sa.o1, 0, 0, 0);
    { bf16x8 pb0, pb1; const TP tb = MB::second(t);
      la_soft<MB>(sb, s1, tb, pb0, pb1);
      sb.o0 = __builtin_amdgcn_mfma_f32_32x32x16_bf16(f.v[0], pb0, sb.o0, 0, 0, 0); sb.o1 = __builtin_amdgcn_mfma_f32_32x32x16_bf16(f.v[2], pb0, sb.o1, 0, 0, 0);
      sb.o0 = __builtin_amdgcn_mfma_f32_32x32x16_bf16(f.v[1], pb1, sb.o0, 0, 0, 0); sb.o1 = __builtin_amdgcn_mfma_f32_32x32x16_bf16(f.v[3], pb1, sb.o1, 0, 0, 0); }
    vs.template load<V1>(f, n.voff);
}
#define LA_RUN2(NT, TILE, MB, V1, KB, VS_) do { Frag f_; { const TP t0_ = TILE(0); la_loadK(f_, KB, t0_); (VS_).template load<V1>(f_, t0_.voff); } \
    _Pragma("unroll 1") for (int i_ = 0; i_ < (NT); ++i_) { const TP t_ = TILE(i_); const TP n_ = TILE(i_ + 1 < (NT) ? i_ + 1 : i_); la_step2<MB, V1>(sa, sb, qa, qb, f_, KB, VS_, t_, n_); } } while (0)
__device__ __forceinline__ int o1_off(int rho, int ch) { return rho * 128 + (((ch + (rho >> 1) + (rho >> 4)) & 15) << 3); }

__device__ __forceinline__ int lam_of(int r32) { return (r32 & 0x13) | ((r32 & 4) << 1) | ((r32 & 8) >> 1); }

__device__ __forceinline__ void la_loadz(u32x2 (&z)[8], const bf16_t* zrow, int hi) {
#pragma unroll
    for (int db = 0; db < 2; ++db)
#pragma unroll
        for (int g = 0; g < 4; ++g) z[4 * db + g] = *(const u32x2*)(zrow + 32 * db + 8 * g + 4 * hi);
}
__device__ __forceinline__ void la_store(const LA& st, bool use_sink, float sink2, const u32x2 (&zv)[8], bf16_t* yrow, int hi) {
    float l = st.l; { auto rr = __builtin_amdgcn_permlane32_swap(__float_as_uint(l), __float_as_uint(l), false, false); l = __uint_as_float(rr[0]) + __uint_as_float(rr[1]); }
    float inv;
    if (use_sink) { const float m2 = fmaxf(st.m, sink2), a = __builtin_amdgcn_exp2f(st.m - m2); inv = a / (l * a + __builtin_amdgcn_exp2f(sink2 - m2)); }
    else inv = 1.f / l;
#pragma unroll
    for (int db = 0; db < 2; ++db)
#pragma unroll
        for (int g = 0; g < 4; ++g) { const int c = 32 * db + 8 * g + 4 * hi; const u32x2 z = zv[4 * db + g];
            const f32x16& o = db ? st.o1 : st.o0;
            u32x2 w; w.x = cvt_pk_bf16(o[4 * g] * inv * silu_f(bf_lo(z.x)), o[4 * g + 1] * inv * silu_f(bf_hi(z.x)));
            w.y = cvt_pk_bf16(o[4 * g + 2] * inv * silu_f(bf_lo(z.y)), o[4 * g + 3] * inv * silu_f(bf_hi(z.y)));
            *(u32x2*)(yrow + c) = w; }
}

#define XB_TMO      128
#define XB_XCNT(j)  (256  + 64 * (j))
#define XB_XSUB(j)  (1280 + 64 * (j))
#define XB_XGEN(j)  (2304 + 64 * (j))
#define XB_TOP      3328
#define XB_TOPGEN   3392
#define XCD_BAR_WORDS 3456
#define XB_SPIN_CAP (1u << 18)

__device__ __forceinline__ unsigned xb_ld(unsigned* p)              { return __hip_atomic_load(p, __ATOMIC_RELAXED, __HIP_MEMORY_SCOPE_AGENT); }
__device__ __forceinline__ unsigned xb_add(unsigned* p, unsigned v) { return __hip_atomic_fetch_add(p, v, __ATOMIC_RELAXED, __HIP_MEMORY_SCOPE_AGENT); }
__device__ __forceinline__ unsigned xb_xcc_id() { return (unsigned)__builtin_amdgcn_s_getreg((3 << 11) | 20) & 0xFu; }
#define XB_SPIN(cond, bar) do { unsigned _sp = 0; while (cond) { __builtin_amdgcn_s_sleep(1); \
    if ((++_sp & 255u) == 0u) { if (xb_ld(&(bar)[XB_TMO])) break; if (_sp > XB_SPIN_CAP) { atomicAdd(&(bar)[XB_TMO], 1u); break; } } } } while (0)

__device__ __forceinline__ unsigned xb_lane() { unsigned l = __builtin_amdgcn_mbcnt_hi(~0u, __builtin_amdgcn_mbcnt_lo(~0u, 0u)); asm volatile("" : "+v"(l)); return l; }
struct XcdBarrier {
    unsigned* bar; unsigned x; unsigned lead;
    volatile LAS unsigned* st;
};

__device__ __forceinline__ XcdBarrier xcd_barrier_post(unsigned* bar, volatile LAS unsigned* st, unsigned lead) {
    XcdBarrier b; b.bar = bar; b.x = xb_xcc_id(); b.st = st; b.lead = lead;
    if (lead != 0u && xb_lane() == 0u) (void)xb_add(&bar[XB_XCNT(b.x)], 1u);
    return b;
}
__device__ __forceinline__ void xcd_barrier_complete(unsigned* bar, unsigned x, unsigned& nloc, unsigned& nx) {
    const unsigned G = gridDim.x * gridDim.y * gridDim.z;
    unsigned sum, cnt, mine, sp = 0u;
    for (;;) {
        sum = 0u; cnt = 0u; mine = 0u;
#pragma unroll
        for (unsigned j = 0; j < 16; ++j) { const unsigned c = xb_ld(&bar[XB_XCNT(j)]); sum += c; cnt += (c > 0u) ? 1u : 0u; mine = (j == x) ? c : mine; }
        if (sum == G) break;
        __builtin_amdgcn_s_sleep(1);
        if ((++sp & 255u) == 0u) { if (xb_ld(&bar[XB_TMO])) break; if (sp > XB_SPIN_CAP) { atomicAdd(&bar[XB_TMO], 1u); break; } }
    }
    nloc = mine > 0u ? mine : 1u; nx = cnt > 0u ? cnt : 1u;
}

__device__ __forceinline__ void xcd_barrier(const XcdBarrier& b) {
    asm volatile("s_waitcnt vmcnt(0)" ::: "memory");
    __syncthreads();
    if (b.lead != 0u && xb_lane() == 0u) {
        unsigned* bar = b.bar;
        __builtin_amdgcn_s_waitcnt(0);
        unsigned nloc = b.st[0], nx = b.st[1];
        if (nloc == 0u) { xcd_barrier_complete(bar, b.x, nloc, nx); b.st[0] = nloc; b.st[1] = nx; }
        const unsigned old = xb_add(&bar[XB_XSUB(b.x)], 1u);
        const unsigned gen = old / nloc;
        if (old + 1u == (gen + 1u) * nloc) {
            __builtin_amdgcn_fence(__ATOMIC_RELEASE, "agent");
            asm volatile("s_waitcnt vmcnt(0)" ::: "memory");
            const unsigned og = xb_add(&bar[XB_TOP], 1u);
            const unsigned tg = og / nx;
            if (og + 1u == (tg + 1u) * nx) xb_add(&bar[XB_TOPGEN], 1u);
            else XB_SPIN(xb_ld(&bar[XB_TOPGEN]) == tg, bar);
            __builtin_amdgcn_fence(__ATOMIC_ACQUIRE, "agent");
            xb_add(&bar[XB_XGEN(b.x)], 1u);
            asm volatile("s_waitcnt vmcnt(0)" ::: "memory");
        } else {
            XB_SPIN(xb_ld(&bar[XB_XGEN(b.x)]) == gen, bar);
            __builtin_amdgcn_fence(__ATOMIC_ACQUIRE, "agent");
            asm volatile("s_waitcnt vmcnt(0)" ::: "memory");
        }
    }
    __syncthreads();
}

__device__ __forceinline__ void convert_items(const float* W, bf16_t* WT, const int N, const int permute, LAS float* scr, const int lane, const int first, const int stride, const int nitems) {
    for (int item = first; item < nitems; item += stride) {
        const int nblk = N / 32, kb = item / nblk, nb = item % nblk, k0 = 64 * kb, n0 = 32 * nb;
        int d0 = n0;
        if (permute && n0 >= 13 * 256 && n0 < 16 * 256) { const int o = n0 & 255, wc = o >> 6, bj = (o >> 5) & 1; d0 = (n0 & ~255) + 128 * bj + 32 * wc; }
        { float tv[32];
#pragma unroll
        for (int i = 0; i < 32; ++i) { const int kk = 2 * i + (lane >> 5); tv[i] = __builtin_nontemporal_load(W + (size_t)(k0 + kk) * N + n0 + (lane & 31)); }
#pragma unroll
        for (int i = 0; i < 32; ++i) { const int kk = 2 * i + (lane >> 5); scr[kk * 33 + (lane & 31)] = tv[i]; } }
        asm volatile("s_waitcnt lgkmcnt(0)" ::: "memory");
        const int c = lane & 7;
#pragma unroll
        for (int j = 0; j < 4; ++j) { const int n = (lane >> 3) + 8 * j; const LAS float* s = scr + (8 * c) * 33 + n;
            u32x4 o; o.x = cvt_pk_bf16(s[0 * 33], s[1 * 33]); o.y = cvt_pk_bf16(s[2 * 33], s[3 * 33]); o.z = cvt_pk_bf16(s[4 * 33], s[5 * 33]); o.w = cvt_pk_bf16(s[6 * 33], s[7 * 33]);
            *(u32x4*)(WT + (size_t)(d0 + n) * DMODEL + k0 + 8 * c) = o; }
        asm volatile("s_waitcnt lgkmcnt(0)" ::: "memory");
    }
}
struct Args { const float* in[13]; float* out; unsigned char* ws; int ph_lo, ph_hi; };

__global__ void __launch_bounds__(NWAVES * 64, 2) mk_fwd(Args args) {
    extern __shared__ __attribute__((aligned(16))) unsigned char lds_raw[];
    LAS unsigned char* lds = (LAS unsigned char*)lds_raw;
    const int G = gridDim.x;
#define PHASE_BEGIN \
    int tid = wave_s * 64 + (int)xb_lane(); asm volatile("" : "+v"(tid)); int bx = blockIdx.x; asm volatile("" : "+s"(bx)); \
    const int lane = tid & 63, wave = __builtin_amdgcn_readfirstlane(tid >> 6); \
    int Gp_ = G; asm volatile("" : "+s"(Gp_)); const int vcu = (Gp_ % 8 == 0) ? (bx % 8) * (Gp_ / 8) + bx / 8 : bx; const int gw = vcu * NWAVES + wave, NGW = G * NWAVES; \
    size_t zoff_ = 0; asm volatile("" : "+s"(zoff_)); unsigned char* ws = args.ws + zoff_; \
    const Args* ka_ = (const Args*)((const char*)__builtin_amdgcn_kernarg_segment_ptr() + zoff_); \
    const float* x_in = ka_->in[0]; const float* c_in = ka_->in[1]; const float* w_ada = ka_->in[2]; const float* b_ada = ka_->in[3]; const float* norm_w = ka_->in[4]; \
    const float* w_in = ka_->in[5]; const float* w_out = ka_->in[6]; const float* attn_sink = ka_->in[7]; const float* na_rpb = ka_->in[8]; \
    const float* q_norm_w = ka_->in[9]; const float* k_norm_w = ka_->in[10]; const float* t5_table = ka_->in[11]; const float* final_norm_w = ka_->in[12]; float* out_p = ka_->out; \
    (void)x_in; (void)c_in; (void)w_ada; (void)b_ada; (void)norm_w; (void)w_in; (void)w_out; (void)attn_sink; (void)na_rpb; (void)q_norm_w; (void)k_norm_w; (void)t5_table; (void)final_norm_w; (void)out_p; \
    float* MODV = (float*)(ws + WS_MODV); float* TABA = (float*)(ws + WS_TABA); float* TABD = (float*)(ws + WS_TABD); float* CS = (float*)(ws + WS_CS); \
    bf16_t* WINT = (bf16_t*)(ws + WS_WINT); bf16_t* WOUTT = (bf16_t*)(ws + WS_WOUTT); bf16_t* Hb = (bf16_t*)(ws + WS_H); bf16_t* PROJ = (bf16_t*)(ws + WS_PROJ); \
    bf16_t* VTA = (bf16_t*)(ws + WS_VTA); bf16_t* VTB = (bf16_t*)(ws + WS_VTB); bf16_t* VTD = (bf16_t*)(ws + WS_VTD); bf16_t* Yb = (bf16_t*)(ws + WS_Y); float* XR = (float*)(ws + WS_XR); \
    (void)lane; (void)wave; (void)gw; (void)NGW; (void)MODV; (void)TABA; (void)TABD; (void)CS; (void)WINT; (void)WOUTT; (void)Hb; (void)PROJ; (void)VTA; (void)VTB; (void)VTD; (void)Yb; (void)XR;
    const int lo = args.ph_lo, hi_ph = args.ph_hi;
#define IN(k) (lo <= (k) && (k) < hi_ph)
    volatile LAS unsigned* bst = (volatile LAS unsigned*)(lds + 131072 + 64);
    const int wave_s = __builtin_amdgcn_readfirstlane((int)threadIdx.x >> 6);
    if (threadIdx.x < 2) bst[threadIdx.x] = 0u;
    __syncthreads();
    const bool one_launch = (lo == 0 && hi_ph == 18);
    const XcdBarrier xbar = xcd_barrier_post((unsigned*)args.ws, bst, (wave_s == 0) ? 1u : 0u);
    (void)one_launch;
#define SEAM(k) do { if (IN(k) && IN((k) + 1)) { if (hi_ph > 1000) cg::this_grid().sync(); else { XcdBarrier xb_ = xbar; unsigned x_ = __builtin_amdgcn_readfirstlane(xb_.x), l_ = __builtin_amdgcn_readfirstlane(xb_.lead); asm volatile("" : "+s"(x_), "+s"(l_)); xb_.x = x_; xb_.lead = l_; xcd_barrier(xb_); } } } while (0)

    if (IN(0)) {
        PHASE_BEGIN
        {
            constexpr int I_IN = (DMODEL / 64) * (NIN / 32);
            convert_items(w_in, WINT, NIN, 1, (LAS float*)(lds + wave * 16384), lane, gw, NGW, I_IN);
        }
        __syncthreads();
        {
            LAS float* cond = (LAS float*)lds; LAS float* red = cond + 2048;
            for (int i = tid; i < 2048; i += 512) cond[i] = silu_f(c_in[i]);
            __syncthreads();
            for (int it = vcu; it < DEPTH * 192; it += G) { const int l = it / 192, c0 = (it % 192) * 32;
                const float* wp = w_ada + (size_t)l * DMODEL * 6144 + c0 + (lane & 31); const int kofs = 2 * wave + (lane >> 5);
                float a0 = 0.f, a1 = 0.f, a2 = 0.f, a3 = 0.f;
#pragma unroll 1
                for (int j = 0; j < 128; j += 16) {
                    float wv[16];
#pragma unroll
                    for (int q = 0; q < 16; ++q) wv[q] = __builtin_nontemporal_load(wp + (size_t)(16 * (j + q) + kofs) * 6144);
#pragma unroll
                    for (int q = 0; q < 16; q += 4) { a0 += cond[16 * (j + q) + kofs] * wv[q]; a1 += cond[16 * (j + q + 1) + kofs] * wv[q + 1];
                        a2 += cond[16 * (j + q + 2) + kofs] * wv[q + 2]; a3 += cond[16 * (j + q + 3) + kofs] * wv[q + 3]; }
                }
                red[(2 * wave + (lane >> 5)) * 32 + (lane & 31)] = (a0 + a1) + (a2 + a3);
                __syncthreads();
                if (tid < 32) { float s = b_ada[l * 6144 + c0 + tid];
#pragma unroll
                    for (int p = 0; p < 16; ++p) s += red[p * 32 + tid];
                    MODV[l * 6144 + c0 + tid] = s; }
                __syncthreads();
            }
        }
        { const int gt = vcu * 512 + tid, NT_ = G * 512;
            for (int i = gt; i < SEQ * 32; i += NT_) { const int t = i >> 5, p = i & 31; const int fi = p & 15; const float pos = (p < 16) ? (float)(t >> 6) : (float)(t & 63);
                const float inv = powf(10000.f, -(float)(2 * fi) / 32.f); const float ang = pos * inv; float sn, cs; sincosf(ang, &sn, &cs); CS[2 * i] = cs; CS[2 * i + 1] = sn; }
            for (int i = gt; i < 8 * TABA_N + 8 * TABD_N; i += NT_) {
                int h, rel; float* dst;
                if (i < 8 * TABA_N) { h = i / TABA_N; rel = i % TABA_N - TABA_C; dst = TABA + i; } else { const int j = i - 8 * TABA_N; h = 8 + j / TABD_N; rel = j % TABD_N - TABD_C; dst = TABD + j; }
                const int n = rel < 0 ? -rel : rel; const float xf = (float)(n > 8 ? n : 8) / 8.f;
                int big = 8 + (int)(logf(xf) / 4.852030263919617f * 8.f); big = big < 15 ? big : 15;
                const int bucket = (rel > 0 ? 16 : 0) + (n < 8 ? n : big);
                *dst = t5_table[bucket * 16 + h] * LOG2E; }
        }
    }
    SEAM(0);

#pragma unroll 1
    for (int l = 0; l < DEPTH; ++l) {
        const int pb = 1 + 4 * l;
        if (IN(pb)) {
            PHASE_BEGIN
            const float* xcur = (l == 0) ? x_in : XR;
            LAS float* gL = (LAS float*)lds; LAS float* sL = gL + 2048;
            for (int i = tid; i < 2048; i += 512) { gL[i] = norm_w[l * 2048 + i] * (1.f + MODV[l * 6144 + 2048 + i]); sL[i] = MODV[l * 6144 + i]; }
            __syncthreads();
            for (int m = gw; m < SEQ; m += NGW) {
                const f32x4* xr = (const f32x4*)(xcur + (size_t)m * DMODEL) + lane;
                f32x4 v[8]; float s = 0.f;
#pragma unroll
                for (int j = 0; j < 8; ++j) { v[j] = xr[64 * j]; s += (v[j][0] * v[j][0] + v[j][1] * v[j][1]) + (v[j][2] * v[j][2] + v[j][3] * v[j][3]); }
                const float rstd = __builtin_amdgcn_rsqf(wave_sum(s) * (1.f / DMODEL) + EPS);
                u32x2* o8 = (u32x2*)(Hb + (size_t)m * DMODEL) + lane;
#pragma unroll
                for (int j = 0; j < 8; ++j) { const f32x4 g = *(const LAS f32x4*)(gL + 4 * lane + 256 * j), sh = *(const LAS f32x4*)(sL + 4 * lane + 256 * j);
                    const f32x4 y = v[j] * rstd * g + sh; u32x2 w; w.x = cvt_pk_bf16(y[0], y[1]); w.y = cvt_pk_bf16(y[2], y[3]); o8[64 * j] = w; }
            }
            __syncthreads();
        }
        SEAM(pb);
        if (IN(pb + 1)) {
            PHASE_BEGIN
            pg8::SchedIn S{(const char*)Hb, (const char*)(WINT + (size_t)l * NIN * DMODEL), G, bx};
            pg8::EpiIn E{PROJ, VTA, VTB, VTD, CS, q_norm_w + l * 64, k_norm_w + l * 64};
            pg8::gemm_phase<pg8::EpiIn, pg8::SchedIn>(tid, lds, DMODEL, S, E);
            const int first_idle = 1728 - 6 * G;
            if (G == 256 ? (bx >= first_idle) : true) {
                const int nidle = (G == 256) ? (G - first_idle) : G, me = (G == 256) ? (bx - first_idle) : bx;
                LAS float* scr = (LAS float*)(lds + wave * 16384);
                constexpr int I_IN = (DMODEL / 64) * (NIN / 32), I_OUT = (DMODEL / 64) * (DMODEL / 32);
                convert_items(w_out + (size_t)l * DMODEL * DMODEL, WOUTT + (size_t)l * DMODEL * DMODEL, DMODEL, 0, scr, lane, me * NWAVES + wave, nidle * NWAVES, I_OUT);
                if (l + 1 < DEPTH) convert_items(w_in + (size_t)(l + 1) * DMODEL * NIN, WINT + (size_t)(l + 1) * NIN * DMODEL, NIN, 1, scr, lane, me * NWAVES + wave, nidle * NWAVES, I_IN);
            }
        }
        SEAM(pb + 1);
        if (IN(pb + 2)) {
            PHASE_BEGIN
            {
                const int h = vcu >> 5;
                float mq = __builtin_fabsf(q_norm_w[l * 64 + lane]), mk = __builtin_fabsf(k_norm_w[l * 64 + lane]);
#pragma unroll
                for (int o_ = 1; o_ < 64; o_ <<= 1) { mq = __builtin_fmaxf(mq, __shfl_xor(mq, o_)); mk = __builtin_fmaxf(mk, __shfl_xor(mk, o_)); }
                const float mfix = __int_as_float(__builtin_amdgcn_readfirstlane(__float_as_int(8.f * mq * mk * LOG2E * 1.02f)));
                for (int u = 0; u < 2; ++u) { const int qb = (vcu & 31) * 2 + u;
                    attn_body::attn_unit<8>(tid, mfix, qb * 256, SEQ / 64, (const attn_body::bf16*)(PROJ + C_QC + h * 64), (const attn_body::bf16*)(PROJ + C_KC + (h >> 2) * 64), (const attn_body::bf16*)(PROJ + C_VC + (h >> 2) * 64),
                                            (const attn_body::bf16*)(PROJ + C_ZC + h * 64), (attn_body::bf16*)(Yb + 1024 + h * 64), (long)PP, (long)DMODEL, (char*)lds_raw); }
            }
            __syncthreads();
        }
        if (IN(pb + 2)) {
            PHASE_BEGIN
            const int h = vcu >> 5, v32 = vcu & 31;
            LAS float* tabA = (LAS float*)lds; LAS float* tabD1 = tabA + TABA_N; LAS float* tabD4 = tabD1 + TABA_N; LAS float* tabD16 = tabD4 + 2052; LAS float* tabNEG = tabD16 + 3076; LAS float* tabB = tabNEG + 512;
            LAS unsigned char* VIM = lds + 36864;
            LAS unsigned char* O1 = VIM; LAS float* LSE1 = (LAS float*)(VIM + 65536);
            {
                float vA = 0.f, vD1 = 0.f, v4[5], v16[7], vB[4]; u32x4 wv[12];
                if (tid < TABA_N) { const int rel = tid - TABA_C; vA = TABA[h * TABA_N + tid]; vD1 = TABD[h * TABD_N + TABD_C + rel]; }
#pragma unroll
                for (int k = 0; k < 5; ++k) { const int i = tid + 512 * k; v4[k] = (i < 2049) ? TABD[h * TABD_N + TABD_C + i - 1024] : 0.f; }
#pragma unroll
                for (int k = 0; k < 7; ++k) { const int i = tid + 512 * k; v16[k] = (i < TABD_N) ? TABD[h * TABD_N + i] : 0.f; }
#pragma unroll
                for (int k = 0; k < 4; ++k) { const int i = tid + 512 * k; const int r = i >> 7, c = (i & 127) - 64 + 15; vB[k] = (i < 15 * 128 && c >= 0 && c < 31) ? na_rpb[((l * 8 + h) * 15 + r) * 31 + c] * LOG2E : 0.f; }
#pragma unroll
                for (int k = 0; k < 12; ++k) { const int p = tid + 512 * k; const int pc = p % 6, c = (p / 6) & 15, d = p / 96; const int s8 = 32 * v32 - 8 + 8 * pc;
                    wv[k] = (u32x4){0u, 0u, 0u, 0u}; if (s8 >= 0 && s8 < 1024) wv[k] = *(const u32x4*)(VTD + vt_off(h * 64 + d, c * 1024 + s8)); }
                if (tid < TABA_N) { const int rel = tid - TABA_C; tabA[tid] = (rel >= -128 && rel <= 128) ? vA : NEGBIG; tabD1[tid] = (rel >= -64 && rel <= 64) ? vD1 : NEGBIG; }
#pragma unroll
                for (int k = 0; k < 5; ++k) { const int i = tid + 512 * k; const int rel = i - 1024; if (i < 2049) tabD4[i] = (rel >= -256 && rel <= 256) ? v4[k] : NEGBIG; }
#pragma unroll
                for (int k = 0; k < 7; ++k) { const int i = tid + 512 * k; const int rel = i - TABD_C; if (i < TABD_N) tabD16[i] = (rel >= -1024 && rel <= 1024) ? v16[k] : NEGBIG; }
                tabNEG[tid] = NEGBIG;
#pragma unroll
                for (int k = 0; k < 4; ++k) { const int i = tid + 512 * k; if (i < 15 * 128) tabB[i] = vB[k]; }
#pragma unroll
                for (int k = 0; k < 12; ++k) { const int p = tid + 512 * k; const int pc = p % 6, c = (p / 6) & 15, d = p / 96;
                    LAS unsigned short* row = (LAS unsigned short*)(VIM + d * VSL_PITCH);
#pragma unroll
                    for (int j = 0; j < 8; ++j) { const int tl = 128 * pc - 64 + 16 * j + c; const unsigned e = (j & 1) ? (wv[k][j >> 1] >> 16) : (wv[k][j >> 1] & 0xffffu); if (tl >= 0 && tl < 640) row[tl] = (unsigned short)e; } }
            }
            __syncthreads();
            const int r32 = lane & 31, hi = lane >> 5, lam = lam_of(r32);
            const LAS char* negp = (const LAS char*)tabNEG;
            const char* PB = (const char*)PROJ;
            {
                const int tl0 = 64 * wave, q0 = 512 * v32 + tl0, tqa = q0 + r32, tqb = tqa + 32;
                bf16x8 qa[4], qb[4]; const bf16_t* qp = PROJ + (size_t)tqa * PP + C_QD + h * 64 + 8 * hi;
#pragma unroll
                for (int d0 = 0; d0 < 4; ++d0) { qa[d0] = *(const bf16x8*)(qp + 16 * d0); qb[d0] = *(const bf16x8*)(qp + (size_t)32 * PP + 16 * d0); }
                LA sa, sb; sa.o0 = zero16(); sa.o1 = sa.o0; sa.m = NEGBIG; sa.l = 0.f; sb.o0 = zero16(); sb.o1 = sb.o0; sb.m = NEGBIG; sb.l = 0.f;
                const unsigned kc = (unsigned)(C_KD + h * 64 + 8 * hi);
                const VSL vs{(const LAS char*)VIM};
                auto tile = [&](int i) -> TP { const int t0r = q0 - 64 + 32 * i; const bool ok = t0r >= 0 && t0r < SEQ; const int t0 = ok ? t0r : q0; TP t;
                    t.koff = ((unsigned)(t0 + lam) * PP + kc) * 2u; t.voff = (unsigned)(r32 * VSL_PITCH + (tl0 + 32 * i + 8 * hi) * 2);
                    t.tp = (ok && i <= 4) ? (const LAS char*)(tabD1 + (TABA_C + t0 + 8 * hi - tqa)) : negp;
                    t.tp2 = (ok && i >= 1) ? (const LAS char*)(tabD1 + (TABA_C + t0 + 8 * hi - tqb)) : negp; t.cb = 0; return t; };
                LA_RUN2(6, tile, MB_A, 32, PB, vs);
                __syncthreads();
#pragma unroll
                for (int w2 = 0; w2 < 2; ++w2) { const LA& st = w2 ? sb : sa;
                    float lt = st.l; { auto rr = __builtin_amdgcn_permlane32_swap(__float_as_uint(lt), __float_as_uint(lt), false, false); lt = __uint_as_float(rr[0]) + __uint_as_float(rr[1]); }
                    const float inv = 1.f / lt; const int rho = tl0 + 32 * w2 + r32;
                    if (hi == 0) LSE1[rho] = st.m + __builtin_amdgcn_logf(lt);
#pragma unroll
                    for (int db = 0; db < 2; ++db)
#pragma unroll
                        for (int g = 0; g < 4; ++g) { const f32x16& o = db ? st.o1 : st.o0; u32x2 w; w.x = cvt_pk_bf16(o[4 * g] * inv, o[4 * g + 1] * inv); w.y = cvt_pk_bf16(o[4 * g + 2] * inv, o[4 * g + 3] * inv);
                            *(LAS u32x2*)(O1 + o1_off(rho, 8 * db + 2 * g + hi)) = w; } }
            }
            {
                const int q0 = 64 * (v32 * 8 + wave), tqa = q0 + r32, tqb = tqa + 32, kvh = h >> 2;
                bf16x8 qa[4], qb[4]; const bf16_t* qp = PROJ + (size_t)tqa * PP + C_QA + h * 64 + 8 * hi;
#pragma unroll
                for (int d0 = 0; d0 < 4; ++d0) { qa[d0] = *(const bf16x8*)(qp + 16 * d0); qb[d0] = *(const bf16x8*)(qp + (size_t)32 * PP + 16 * d0); }
                LA sa, sb; sa.o0 = zero16(); sa.o1 = sa.o0; sa.m = NEGBIG; sa.l = 0.f; sb.o0 = zero16(); sb.o1 = sb.o0; sb.m = NEGBIG; sb.l = 0.f;
                u32x2 za[8], zb[8]; la_loadz(za, PROJ + (size_t)tqa * PP + C_ZA + h * 64, hi); la_loadz(zb, PROJ + (size_t)tqb * PP + C_ZA + h * 64, hi);
                const int vd = kvh * 64 + r32; const unsigned kc = (unsigned)(C_KA + kvh * 64 + 8 * hi);
                const VSG vs{(const char*)VTA};
                auto tile = [&](int i) -> TP { const int t0r = q0 - 128 + 32 * i; const bool ok = t0r >= 0 && t0r < SEQ; const int t0 = ok ? t0r : q0; TP t;
                    t.koff = ((unsigned)(t0 + lam) * PP + kc) * 2u; t.voff = (unsigned)(vt_off(vd, t0 + 8 * hi) * 2);
                    t.tp = (ok && i <= 8) ? (const LAS char*)(tabA + (TABA_C + t0 + 8 * hi - tqa)) : negp;
                    t.tp2 = (ok && i >= 1) ? (const LAS char*)(tabA + (TABA_C + t0 + 8 * hi - tqb)) : negp; t.cb = 0; return t; };
                LA_RUN2(10, tile, MB_A, 32, PB, vs);
                const float sk2 = attn_sink[l * 8 + h] * LOG2E;
                la_store(sa, true, sk2, za, Yb + (size_t)tqa * DMODEL + h * 64, hi);
                la_store(sb, true, sk2, zb, Yb + (size_t)tqb * DMODEL + h * 64, hi);
            }
            {
                const int qh = wave & 1, qrow = 8 * v32 + 2 * (wave >> 1), qc = 32 * qh + r32, tqa = 64 * qrow + qc, tqb = tqa + 64;
                int rsa = qrow - 4; rsa = rsa < 0 ? 0 : (rsa > 248 ? 248 : rsa); int rsb = qrow - 3; rsb = rsb < 0 ? 0 : (rsb > 248 ? 248 : rsb); int cs = qc - 8; cs = cs < 0 ? 0 : (cs > 48 ? 48 : cs);
                bf16x8 qa[4], qb[4]; const bf16_t* qp = PROJ + (size_t)tqa * PP + C_QB + h * 64 + 8 * hi;
#pragma unroll
                for (int d0 = 0; d0 < 4; ++d0) { qa[d0] = *(const bf16x8*)(qp + 16 * d0); qb[d0] = *(const bf16x8*)(qp + (size_t)64 * PP + 16 * d0); }
                LA sa, sb; sa.o0 = zero16(); sa.o1 = sa.o0; sa.m = NEGBIG; sa.l = 0.f; sb.o0 = zero16(); sb.o1 = sb.o0; sb.m = NEGBIG; sb.l = 0.f;
                const int vd = h * 64 + r32; const unsigned kc = (unsigned)(C_KB + h * 64 + 8 * hi);
                const VSG vs{(const char*)VTB};
                const LAS char* bb0 = (const LAS char*)(tabB + ((7 - qrow) * 128 + 32 * qh + 8 * hi - qc + 64));
                const int cbr = 32 * qh + 8 * hi - cs;
                auto tile = [&](int i) -> TP { const int kr = rsa + i, krc = kr > 255 ? 255 : kr, t0 = 64 * krc + 32 * qh; const bool va = i <= 7, vb = kr >= rsb && kr < rsb + 8; TP t;
                    t.koff = ((unsigned)(t0 + lam) * PP + kc) * 2u; t.voff = (unsigned)(vt_off(vd, t0 + 8 * hi) * 2);
                    const LAS char* bp = bb0 + kr * 512;
                    t.tp = va ? bp : negp; t.tp2 = vb ? bp - 512 : negp; t.cb = cbr; return t; };
                LA_RUN2(9, tile, MB_B, 32, PB, vs);
                const int c0 = qh ? 24 : 32;
                {   LA& st = sa; const bf16x8 (&qf)[4] = qa;
                    auto tilx = [&](int i) -> TP { const int kr0 = rsa + 4 * i, t0 = 64 * kr0 + c0, tk = t0 + (lam & 7) + (lam >> 3) * 64; TP t;
                        t.koff = ((unsigned)tk * PP + kc) * 2u; t.voff = (unsigned)(vt_off(vd, t0 + hi * 64) * 2);
                        t.tp = (const LAS char*)(tabB + ((kr0 + hi - qrow + 7) * 128 + c0 - qc + 64)); t.cb = c0 - cs; t.tp2 = t.tp; return t; };
                    LA_RUN(2, tilx, MB_BX, 512, PB, vs); }
                {   LA& st = sb; const bf16x8 (&qf)[4] = qb;
                    auto tilx = [&](int i) -> TP { const int kr0 = rsb + 4 * i, t0 = 64 * kr0 + c0, tk = t0 + (lam & 7) + (lam >> 3) * 64; TP t;
                        t.koff = ((unsigned)tk * PP + kc) * 2u; t.voff = (unsigned)(vt_off(vd, t0 + hi * 64) * 2);
                        t.tp = (const LAS char*)(tabB + ((kr0 + hi - qrow - 1 + 7) * 128 + c0 - qc + 64)); t.cb = c0 - cs; t.tp2 = t.tp; return t; };
                    LA_RUN(2, tilx, MB_BX, 512, PB, vs); }
                u32x2 zv[8];
                la_loadz(zv, PROJ + (size_t)tqa * PP + C_ZB + h * 64, hi); la_store(sa, false, 0.f, zv, Yb + (size_t)tqa * DMODEL + 512 + h * 64, hi);
                la_loadz(zv, PROJ + (size_t)tqb * PP + C_ZB + h * 64, hi); la_store(sb, false, 0.f, zv, Yb + (size_t)tqb * DMODEL + 512 + h * 64, hi);
            }
            __syncthreads();
            {
                const int cA = (wave & 3) + 8 * (wave >> 2), cB = cA + 4, s0 = 32 * v32, tqa = 16 * (s0 + r32) + cA, tqb = tqa + 4;
                bf16x8 qa[4], qb[4]; const bf16_t* qp = PROJ + (size_t)tqa * PP + C_QD + h * 64 + 8 * hi;
#pragma unroll
                for (int d0 = 0; d0 < 4; ++d0) { qa[d0] = *(const bf16x8*)(qp + 16 * d0); qb[d0] = *(const bf16x8*)(qp + (size_t)4 * PP + 16 * d0); }
                LA sa, sb;
#pragma unroll
                for (int w2 = 0; w2 < 2; ++w2) { LA& st = w2 ? sb : sa; const int rho = 16 * r32 + (w2 ? cB : cA);
                    st.m = LSE1[rho]; st.l = hi ? 0.f : 1.f;
#pragma unroll
                    for (int db = 0; db < 2; ++db)
#pragma unroll
                        for (int g = 0; g < 4; ++g) { const u32x2 w = *(const LAS u32x2*)(O1 + o1_off(rho, 8 * db + 2 * g + hi));
                            if (db) { st.o1[4 * g] = bf_lo(w.x); st.o1[4 * g + 1] = bf_hi(w.x); st.o1[4 * g + 2] = bf_lo(w.y); st.o1[4 * g + 3] = bf_hi(w.y); }
                            else { st.o0[4 * g] = bf_lo(w.x); st.o0[4 * g + 1] = bf_hi(w.x); st.o0[4 * g + 2] = bf_lo(w.y); st.o0[4 * g + 3] = bf_hi(w.y); } } }
                const int vd = h * 64 + r32; const unsigned kc = (unsigned)(C_KD + h * 64 + 8 * hi);
                const VSG vs{(const char*)VTD};
                {
                    LA& st = sa; const bf16x8 (&qf)[4] = qa;
                    auto t16 = [&](int i) -> TP { const int sbr = s0 - 64 + 32 * i; const bool ok = sbr >= 0 && sbr < 1024; const int sb_ = ok ? sbr : s0;
                        const int t0 = 16 * sb_ + cA, tk = t0 + (lam & 7) * 16 + (lam >> 3) * 128; TP t;
                        t.koff = ((unsigned)tk * PP + kc) * 2u; t.voff = (unsigned)(vt_off(vd, cA * 1024 + sb_ + 8 * hi) * 2);
                        t.tp = ok ? (const LAS char*)(tabD16 + (TABD_C + t0 + hi * 128 - tqa)) : negp; t.cb = 0; t.tp2 = t.tp; return t; };
                    LA_RUN(5, t16, MB_D16, 32, PB, vs);
                }
                {
                    LA& st = sb; const bf16x8 (&qf)[4] = qb;
                    auto t16 = [&](int i) -> TP { const int sbr = s0 - 64 + 32 * i; const bool ok = sbr >= 0 && sbr < 1024; const int sb_ = ok ? sbr : s0;
                        const int t0 = 16 * sb_ + cB, tk = t0 + (lam & 7) * 16 + (lam >> 3) * 128; TP t;
                        t.koff = ((unsigned)tk * PP + kc) * 2u; t.voff = (unsigned)(vt_off(vd, cB * 1024 + sb_ + 8 * hi) * 2);
                        t.tp = ok ? (const LAS char*)(tabD16 + (TABD_C + t0 + hi * 128 - tqb)) : negp; t.cb = 0; t.tp2 = t.tp; return t; };
                    LA_RUN(5, t16, MB_D16, 32, PB, vs);
                }
                auto t4 = [&](int i) -> TP { const int cq = (cA & 3) + 4 * (i >> 1), sb_ = s0 - 16 + 32 * (i & 1);
                    const int t0 = 16 * sb_ + cq; int tk = t0 + (lam & 7) * 16 + (lam >> 3) * 128; tk = tk < 0 ? 0 : (tk > SEQ - 1 ? SEQ - 1 : tk); TP t;
                    t.koff = ((unsigned)tk * PP + kc) * 2u; t.voff = (unsigned)(vt_off(vd, cq * 1024 + sb_ + 8 * hi) * 2);
                    t.tp = (const LAS char*)(tabD4 + (1024 + t0 + hi * 128 - tqa)); t.tp2 = t.tp - 16; t.cb = (sb_ < 0 ? 1 : 0) | (sb_ + 32 > 1024 ? 2 : 0); return t; };
                LA_RUN2(8, t4, MB_D4M, 96, PB, vs);
                u32x2 zv[8];
                la_loadz(zv, PROJ + (size_t)tqa * PP + C_ZD + h * 64, hi); la_store(sa, false, 0.f, zv, Yb + (size_t)tqa * DMODEL + 1536 + h * 64, hi);
                la_loadz(zv, PROJ + (size_t)tqb * PP + C_ZD + h * 64, hi); la_store(sb, false, 0.f, zv, Yb + (size_t)tqb * DMODEL + 1536 + h * 64, hi);
            }
            __syncthreads();
        }
        SEAM(pb + 2);
        if (IN(pb + 3)) {
            PHASE_BEGIN
            const float* xcur = (l == 0) ? x_in : XR;
            pg8::SchedOut S{(const char*)Yb, (const char*)(WOUTT + (size_t)l * DMODEL * DMODEL), G, bx};
            pg8::EpiOut E{xcur, XR, MODV + l * 6144 + 4096};
            pg8::gemm_phase<pg8::EpiOut, pg8::SchedOut>(tid, lds, DMODEL, S, E);
        }
        SEAM(pb + 3);
    }
    if (IN(17)) {
        PHASE_BEGIN
        for (int m = gw; m < SEQ; m += NGW) {
            const f32x4* xr = (const f32x4*)(XR + (size_t)m * DMODEL) + lane;
            f32x4 v[8]; float s = 0.f;
#pragma unroll
            for (int j = 0; j < 8; ++j) { v[j] = xr[64 * j]; s += (v[j][0] * v[j][0] + v[j][1] * v[j][1]) + (v[j][2] * v[j][2] + v[j][3] * v[j][3]); }
            const float rstd = __builtin_amdgcn_rsqf(wave_sum(s) * (1.f / DMODEL) + EPS);
            f32x4* o = (f32x4*)(out_p + (size_t)m * DMODEL) + lane;
#pragma unroll
            for (int j = 0; j < 8; ++j) { const f32x4 g = *((const f32x4*)final_norm_w + lane + 64 * j); o[64 * j] = v[j] * rstd * g; }
        }
    }
#undef IN
#undef SEAM
}

extern "C" void kernel_launch(void* const* d_in, const int* in_sizes, int n_in, void* d_out, int out_size, void* d_ws, size_t ws_size, hipStream_t stream) {
    static int grid = 0;
    if (grid == 0) {
        if (n_in != 13 || ws_size < WS_END) { fprintf(stderr, "kernel_launch: unexpected inputs (n_in %d, ws %zu)\n", n_in, ws_size); grid = -1; return; }
        int dev = 0, cus = 0, per_cu = 0;
        (void)hipGetDevice(&dev); (void)hipDeviceGetAttribute(&cus, hipDeviceAttributeMultiprocessorCount, dev);
        (void)hipFuncSetAttribute((const void*)mk_fwd, hipFuncAttributeMaxDynamicSharedMemorySize, LDS_BYTES);
        (void)hipOccupancyMaxActiveBlocksPerMultiprocessor(&per_cu, (const void*)mk_fwd, NWAVES * 64, LDS_BYTES);
        (void)hipGetLastError();
        if (per_cu < 1) fprintf(stderr, "kernel_launch: occupancy query says %d blocks per CU\n", per_cu);
        grid = cus;
    }
    if (grid < 0) return;
    (void)hipMemsetAsync(d_ws, 0, 16384, stream);
    Args a{};
    for (int i = 0; i < 13; ++i) a.in[i] = (const float*)d_in[i];
    a.out = (float*)d_out; a.ws = (unsigned char*)d_ws;
#if MK_ONE_LAUNCH
    a.ph_lo = 0; a.ph_hi = 18;
    void* kargs[] = {&a};
    hipError_t e = hipLaunchCooperativeKernel((const void*)mk_fwd, dim3(grid), dim3(NWAVES * 64), kargs, LDS_BYTES, stream);
    if (e != hipSuccess) fprintf(stderr, "cooperative launch failed: %s (grid %d)\n", hipGetErrorString(e), grid);
#else
    for (int p = 0; p < 18; ++p) { a.ph_lo = p; a.ph_hi = p + 1; hipLaunchKernelGGL(mk_fwd, dim3(grid), dim3(NWAVES * 64), LDS_BYTES, stream, a); }
#endif
}
```
